# Optimizing an MI355X kernel written in HIP

```python
import math
import jax, jax.numpy as jnp
from jax import lax
import numpy as np

D_MODEL = 1024
BATCH = 16
SEQ = 4096
DEPTH = 2

N_HEADS = 16
HEAD_DIM = D_MODEL // N_HEADS
D_FF = ((8 * D_MODEL // 3) + 255) // 256 * 256
CONV_WIDTH = 3
DILATED_BRANCHES = ((128, 1), (512, 4), (2048, 16))
BLOCK = 128
REL_BUCKETS = 32
REL_MAX_DISTANCE = 2048
N_A_LAYERS = DEPTH // 2
N_B_LAYERS = DEPTH - N_A_LAYERS
RMS_EPS = 1e-6

kernel_name = "yoco_shortconv_dilated_attention_trunk"


def rmsnorm(x, g):
    xf = x.astype(jnp.float32)
    y = xf * lax.rsqrt(jnp.mean(xf * xf, axis=-1, keepdims=True) + RMS_EPS)
    return (y * g.astype(jnp.float32)).astype(x.dtype)


def causal_dwconv(x, w, b=None):
    S = x.shape[1]
    xp = jnp.pad(x, ((0, 0), (CONV_WIDTH - 1, 0), (0, 0)))
    y = xp[:, 0:S] * w[0]
    for tap in range(1, CONV_WIDTH):
        y = y + xp[:, tap:tap + S] * w[tap]
    if b is not None:
        y = y + b
    return y


def t5_bucket(dist):
    max_exact = REL_BUCKETS // 2
    n = jnp.maximum(dist, 0)
    nf = jnp.maximum(n, max_exact).astype(jnp.float32)
    large = max_exact + (jnp.log(nf / max_exact) / math.log(REL_MAX_DISTANCE / max_exact)
                         * (REL_BUCKETS - max_exact)).astype(jnp.int32)
    large = jnp.minimum(large, REL_BUCKETS - 1)
    return jnp.where(n < max_exact, n, large)


def short_conv_mixer(xn, w_in, conv_w, w_out):
    b_gate, c_gate, h = jnp.split(xn @ w_in, 3, axis=-1)
    return (b_gate * causal_dwconv(c_gate * h, conv_w)) @ w_out


def conv_ffn(xn, w_up, conv_w, conv_b, w_down):
    u = causal_dwconv(xn @ w_up, conv_w, conv_b)
    g, up = jnp.split(u, 2, axis=-1)
    return (jax.nn.silu(g) * up) @ w_down


def dilated_branch(q, k, v, rel_bias, window, dilation):
    B, S, H, Dh = q.shape
    P = BLOCK
    W = window // dilation
    L = S // dilation
    Lp = -(-L // P) * P
    nb = Lp // P

    def to_sub(t):
        return t.reshape(B, L, dilation, H, Dh).transpose(2, 0, 1, 3, 4)

    def to_blocks(t):
        return (t.reshape(dilation, B, nb, P, H, Dh).transpose(0, 2, 1, 3, 4, 5)
                .reshape(dilation * nb, B, P, H, Dh))

    qs = jnp.pad(to_sub(q), ((0, 0), (0, 0), (0, Lp - L), (0, 0), (0, 0)))
    ks = jnp.pad(to_sub(k), ((0, 0), (0, 0), (P, Lp - L), (0, 0), (0, 0)))
    vs = jnp.pad(to_sub(v), ((0, 0), (0, 0), (P, Lp - L), (0, 0), (0, 0)))
    q_blk = to_blocks(qs)
    k_prev, k_cur = to_blocks(ks[:, :, :Lp]), to_blocks(ks[:, :, P:])
    v_prev, v_cur = to_blocks(vs[:, :, :Lp]), to_blocks(vs[:, :, P:])
    blk_idx = jnp.tile(jnp.arange(nb, dtype=jnp.int32), dilation)

    qi = jnp.arange(P, dtype=jnp.int32)[:, None]
    kc = jnp.arange(2 * P, dtype=jnp.int32)[None, :]
    delta = qi + P - kc
    band = (delta >= 0) & (delta <= W)
    bias = rel_bias[t5_bucket(delta * dilation)].astype(jnp.float32).transpose(2, 0, 1)
    scale = HEAD_DIM ** -0.5

    def block_fn(args):
        qb, kp, kcur, vp, vcur, j = args
        kw = jnp.concatenate([kp, kcur], axis=1).astype(jnp.float32)
        vw = jnp.concatenate([vp, vcur], axis=1).astype(jnp.float32)
        s = jnp.einsum('bqhd,bkhd->bhqk', qb.astype(jnp.float32), kw) * scale + bias
        valid = band & ((j * P + kc - P) >= 0)
        s = jnp.where(valid, s, -jnp.inf)
        m = jnp.max(s, axis=-1)
        p = jnp.exp(s - m[..., None])
        den = jnp.sum(p, axis=-1)
        num = jnp.einsum('bhqk,bkhd->bqhd', p, vw)
        return num, den.transpose(0, 2, 1), m.transpose(0, 2, 1)

    num, den, mx = lax.map(block_fn, (q_blk, k_prev, k_cur, v_prev, v_cur, blk_idx))

    def from_blocks(t):
        t = t.reshape((dilation, nb, B, P) + t.shape[3:])
        t = jnp.moveaxis(jnp.moveaxis(t, 0, 3), 0, 1)
        t = t.reshape((B, Lp, dilation) + t.shape[4:])[:, :L]
        return t.reshape((B, S) + t.shape[3:])

    return from_blocks(num), from_blocks(den), from_blocks(mx)


def dilated_attention(xn, w_q, w_o, k, v, rel_bias):
    B, S, _ = xn.shape
    q = (xn @ w_q).reshape(B, S, N_HEADS, HEAD_DIM)
    branches = [dilated_branch(q, k, v, rel_bias, w, d) for (w, d) in DILATED_BRANCHES]
    m_all = jnp.max(jnp.stack([br[2] for br in branches]), axis=0)
    num_tot = jnp.zeros(q.shape, jnp.float32)
    den_tot = jnp.zeros(m_all.shape, jnp.float32)
    for num, den, mx in branches:
        wgt = jnp.exp(mx - m_all)
        num_tot = num_tot + wgt[..., None] * num
        den_tot = den_tot + wgt * den
    out = (num_tot / den_tot[..., None]).astype(xn.dtype).reshape(B, S, D_MODEL)
    return out @ w_o


def setup_inputs(seed: int = 0) -> dict:
    key = jax.random.key(seed)
    ks = jax.random.split(key, 17)
    f32 = jnp.float32
    D, F = D_MODEL, D_FF

    def nrm(k, shape, scale):
        return jax.random.normal(k, shape, f32) * scale

    def gain(k, shape):
        return 1.0 + 0.02 * jax.random.normal(k, shape, f32)

    return {
        "x": nrm(ks[0], (BATCH, SEQ, D), 1.0),
        "a_norm": gain(ks[1], (N_A_LAYERS, D)),
        "a_w_in": nrm(ks[2], (N_A_LAYERS, D, 3 * D), D ** -0.5),
        "a_conv": nrm(ks[3], (N_A_LAYERS, CONV_WIDTH, D), CONV_WIDTH ** -0.5),
        "a_w_out": nrm(ks[4], (N_A_LAYERS, D, D), D ** -0.5),
        "kv_norm": gain(ks[5], (D,)),
        "w_kv": nrm(ks[6], (D, 2 * D), D ** -0.5),
        "b_norm": gain(ks[7], (N_B_LAYERS, D)),
        "b_w_q": nrm(ks[8], (N_B_LAYERS, D, D), D ** -0.5),
        "b_w_o": nrm(ks[9], (N_B_LAYERS, D, D), D ** -0.5),
        "rel_bias": nrm(ks[10], (REL_BUCKETS, N_HEADS), 0.5),
        "ffn_norm": gain(ks[11], (DEPTH, D)),
        "ffn_w_up": nrm(ks[12], (DEPTH, D, 2 * F), D ** -0.5),
        "ffn_conv": nrm(ks[13], (DEPTH, CONV_WIDTH, 2 * F), CONV_WIDTH ** -0.5),
        "ffn_conv_b": nrm(ks[14], (DEPTH, 2 * F), 0.02),
        "ffn_w_down": nrm(ks[15], (DEPTH, F, D), F ** -0.5),
        "final_norm": gain(ks[16], (D,)),
    }


def reference(x, a_norm, a_w_in, a_conv, a_w_out, kv_norm, w_kv, b_norm, b_w_q, b_w_o, rel_bias,
              ffn_norm, ffn_w_up, ffn_conv, ffn_conv_b, ffn_w_down, final_norm):
    B, S, _ = x.shape
    h = x
    k = v = None
    for l in range(DEPTH):
        if l < N_A_LAYERS:
            h = h + short_conv_mixer(rmsnorm(h, a_norm[l]), a_w_in[l], a_conv[l], a_w_out[l])
        else:
            j = l - N_A_LAYERS
            h = h + dilated_attention(rmsnorm(h, b_norm[j]), b_w_q[j], b_w_o[j], k, v, rel_bias)
        h = h + conv_ffn(rmsnorm(h, ffn_norm[l]), ffn_w_up[l], ffn_conv[l], ffn_conv_b[l], ffn_w_down[l])
        if l == N_A_LAYERS - 1:
            k_flat, v_flat = jnp.split(rmsnorm(h, kv_norm) @ w_kv, 2, axis=-1)
            k = k_flat.reshape(B, S, N_HEADS, HEAD_DIM)
            v = v_flat.reshape(B, S, N_HEADS, HEAD_DIM)
    return rmsnorm(h, final_norm)
```

```cpp
#include <hip/hip_runtime.h>
#include <hip/hip_cooperative_groups.h>
#include <cstdio>
#include <cstdint>
namespace cg = cooperative_groups;

constexpr int DM = 1024, NB = 16, SEQ = 4096, MT = NB * SEQ  , NH = 16, HD = 64, FF = 2816, FF2 = 2 * FF;
constexpr float RMS_EPS = 1e-6f;
constexpr float LOG2E = 1.4426950408889634f;

namespace pg8 {
#define PG8_LAS __attribute__((address_space(3)))
typedef unsigned short bf16_t;
typedef short bf16x8 __attribute__((ext_vector_type(8)));
typedef float f32x4 __attribute__((ext_vector_type(4)));
typedef unsigned u32x4 __attribute__((ext_vector_type(4)));
constexpr int BM = 256, BK = 64, HALF = 128, HTB = HALF * BK * 2  , STAGE_BYTES = 8 * HTB, NXCD = 8, WGM = 8;

__host__ __device__ __forceinline__ int lds_byte(int r, int c) { const int st = (r >> 4) * 2 + (c >> 5), rr = r & 15, cc = c & 31, ob = rr * 64 + cc * 2; return st * 1024 + (ob ^ (((ob >> 9) & 1) << 5)); }
__host__ __device__ __forceinline__ void stage_rc(int b, int& R, int& C) { const int st = b / 1024, sb = b % 1024, swz = sb ^ (((sb >> 9) & 1) << 5); R = (st >> 1) * 16 + swz / 64; C = (st & 1) * 32 + (swz % 64) / 2; }
__host__ __device__ __forceinline__ int perm32(int rho) { const int n = rho >> 4, i = rho & 15; return 8 * (i >> 2) + 4 * n + (i & 3); }

struct Unit { int pm, pn; };
struct Gemm { const bf16_t* A; const bf16_t* Bt; int M, N, K; };

struct StaticOrder {
    int nM, nN, nwg, G, c;
    __host__ __device__ void init(int M, int N, int G_, int c_) { nM = M / BM; nN = N / BM; nwg = nM * nN; G = G_; c = c_; }
    __host__ __device__ bool next(int i, Unit& u) const {
        const long L = (long)i * G + c; if (L >= nwg) return false;
        int wgid = (int)L; { const int q = nwg / NXCD, r = nwg % NXCD, xcd = wgid % NXCD, off = wgid / NXCD; wgid = (xcd < r ? xcd * (q + 1) : r * (q + 1) + (xcd - r) * q) + off; }
        const int nig = WGM * nN, gid = wgid / nig, fm = gid * WGM, gsz = (nM - fm) < WGM ? (nM - fm) : WGM;
        u.pm = fm + ((wgid % nig) % gsz); u.pn = (wgid % nig) / gsz; return true;
    }
    __device__ __forceinline__ void a_ready(const Unit&) const {}
    __device__ __forceinline__ void done(const Unit&) const {}
};

typedef float f32x2_c __attribute__((ext_vector_type(2))); typedef __bf16 bf16x2_c __attribute__((ext_vector_type(2)));
__device__ __forceinline__ unsigned cvt_pk_bf16(float lo, float hi) { const f32x2_c v = {lo, hi}; const bf16x2_c b = __builtin_convertvector(v, bf16x2_c); return __builtin_bit_cast(unsigned, b); }
__device__ __forceinline__ float row_rstd(const float* SS, int row) {
    const f32x4 p = *(const f32x4*)(SS + (size_t)row * 4);
    const float s = (p[0] + p[1]) + (p[2] + p[3]);
    return __builtin_amdgcn_rsqf(s * (1.0f / DM) + RMS_EPS);
}
#define EPI_ARGS f32x4 (&acc)[2][2][4][2], const Unit& u, int wr, int wc, int fr, int fq, PG8_LAS unsigned char* ldsx, int ui, int wid, int lane

struct EpiWin {
    static constexpr bool PERM = true, AFTER_DRAIN = false;
    bf16_t* Bg; bf16_t* CH;
    __device__ __forceinline__ void operator()(EPI_ARGS) const {
        const int row0 = u.pm * BM + wr * 64 + fr;
        if (u.pn < 4) {
            const int col0 = u.pn * BM + wc * 32 + 8 * fq;
#pragma unroll
            for (int ai = 0; ai < 2; ++ai)
#pragma unroll
                for (int m = 0; m < 4; ++m) { bf16_t* rowp = Bg + (size_t)(row0 + ai * HALF + m * 16) * DM + col0;
#pragma unroll
                    for (int bj = 0; bj < 2; ++bj) { const f32x4 v0 = acc[ai][bj][m][0], v1 = acc[ai][bj][m][1];
                        u32x4 w; w.x = cvt_pk_bf16(v0[0], v0[1]); w.y = cvt_pk_bf16(v0[2], v0[3]); w.z = cvt_pk_bf16(v1[0], v1[1]); w.w = cvt_pk_bf16(v1[2], v1[3]);
                        __builtin_nontemporal_store(w, (u32x4*)(rowp + bj * HALF)); } }
        } else {
            const int col0 = (u.pn - 4) * HALF + wc * 32 + 8 * fq;
#pragma unroll
            for (int ai = 0; ai < 2; ++ai)
#pragma unroll
                for (int m = 0; m < 4; ++m) { bf16_t* rowp = CH + (size_t)(row0 + ai * HALF + m * 16) * DM + col0;
                    const f32x4 v0 = acc[ai][0][m][0] * acc[ai][1][m][0], v1 = acc[ai][0][m][1] * acc[ai][1][m][1];
                    u32x4 w; w.x = cvt_pk_bf16(v0[0], v0[1]); w.y = cvt_pk_bf16(v0[2], v0[3]); w.z = cvt_pk_bf16(v1[0], v1[1]); w.w = cvt_pk_bf16(v1[2], v1[3]);
                    __builtin_nontemporal_store(w, (u32x4*)rowp); }
        }
    }
};

struct EpiQKV {
    static constexpr bool PERM = true, AFTER_DRAIN = false;
    bf16_t* QKV; const float* SS; float qscale;
    __device__ __forceinline__ void operator()(EPI_ARGS) const {
        const int row0 = u.pm * BM + wr * 64 + fr; const int t = u.pn >> 2;
        bf16_t* base = QKV + (size_t)t * MT * DM; const float sc = t == 0 ? qscale : 1.0f;
        const int head0 = (u.pn & 3) * 4 + (wc >> 1), d0 = (wc & 1) * 32 + 8 * fq;
        float rsv[2][4];
#pragma unroll
        for (int ai = 0; ai < 2; ++ai)
#pragma unroll
            for (int m = 0; m < 4; ++m) rsv[ai][m] = row_rstd(SS, row0 + ai * HALF + m * 16) * sc;
#pragma unroll
        for (int ai = 0; ai < 2; ++ai)
#pragma unroll
            for (int m = 0; m < 4; ++m) { const int row = row0 + ai * HALF + m * 16; const float rs = rsv[ai][m]; const int bb = row >> 12, tt = row & (SEQ - 1);
#pragma unroll
                for (int bj = 0; bj < 2; ++bj) { const f32x4 v0 = acc[ai][bj][m][0] * rs, v1 = acc[ai][bj][m][1] * rs;
                    u32x4 w; w.x = cvt_pk_bf16(v0[0], v0[1]); w.y = cvt_pk_bf16(v0[2], v0[3]); w.z = cvt_pk_bf16(v1[0], v1[1]); w.w = cvt_pk_bf16(v1[2], v1[3]);
                    __builtin_nontemporal_store(w, (u32x4*)(base + ((size_t)(bb * NH + head0 + 2 * bj) * SEQ + tt) * HD + d0)); } }
    }
};

__device__ __forceinline__ float bf2f_lo(unsigned w) { return __builtin_bit_cast(float, w << 16); }
__device__ __forceinline__ float bf2f_hi(unsigned w) { return __builtin_bit_cast(float, w & 0xffff0000u); }
template <bool BASE_F32> struct EpiRes {
    static constexpr bool PERM = true, AFTER_DRAIN = false;
    const float* basef; bf16_t* Hb; float* SS;
    __device__ __forceinline__ void operator()(EPI_ARGS) const {
        PG8_LAS float* red = (PG8_LAS float*)(ldsx + (ui & 1) * 8192);
        const int row0 = u.pm * BM + wr * 64 + fr; const int col0 = u.pn * BM + wc * 32 + 8 * fq;
        if (BASE_F32) {
#pragma unroll
            for (int ai = 0; ai < 2; ++ai) {
                f32x4 b0[4][2], b1[4][2];
#pragma unroll
                for (int m = 0; m < 4; ++m) { const size_t off = (size_t)(row0 + ai * HALF + m * 16) * DM + col0;
#pragma unroll
                    for (int bj = 0; bj < 2; ++bj) { b0[m][bj] = *(const f32x4*)(basef + off + bj * HALF); b1[m][bj] = *(const f32x4*)(basef + off + bj * HALF + 4); } }
#pragma unroll
                for (int m = 0; m < 4; ++m) { const size_t off = (size_t)(row0 + ai * HALF + m * 16) * DM + col0; float ssq = 0.f;
#pragma unroll
                    for (int bj = 0; bj < 2; ++bj) {
                        const f32x4 v0 = acc[ai][bj][m][0] + b0[m][bj], v1 = acc[ai][bj][m][1] + b1[m][bj];
                        ssq += (v0[0] * v0[0] + v0[1] * v0[1]) + (v0[2] * v0[2] + v0[3] * v0[3]) + (v1[0] * v1[0] + v1[1] * v1[1]) + (v1[2] * v1[2] + v1[3] * v1[3]);
                        u32x4 w; w.x = cvt_pk_bf16(v0[0], v0[1]); w.y = cvt_pk_bf16(v0[2], v0[3]); w.z = cvt_pk_bf16(v1[0], v1[1]); w.w = cvt_pk_bf16(v1[2], v1[3]);
                        __builtin_nontemporal_store(w, (u32x4*)(Hb + off + bj * HALF)); }
                    ssq += __shfl_xor(ssq, 16); ssq += __shfl_xor(ssq, 32);
                    if (fq == 0) red[wc * 256 + ai * HALF + wr * 64 + m * 16 + fr] = ssq; }
            }
        } else {
            u32x4 hb[2][4][2];
#pragma unroll
            for (int ai = 0; ai < 2; ++ai)
#pragma unroll
                for (int m = 0; m < 4; ++m) { const size_t off = (size_t)(row0 + ai * HALF + m * 16) * DM + col0;
#pragma unroll
                    for (int bj = 0; bj < 2; ++bj) hb[ai][m][bj] = *(const u32x4*)(Hb + off + bj * HALF); }
#pragma unroll
            for (int ai = 0; ai < 2; ++ai)
#pragma unroll
                for (int m = 0; m < 4; ++m) { const size_t off = (size_t)(row0 + ai * HALF + m * 16) * DM + col0; float ssq = 0.f;
#pragma unroll
                    for (int bj = 0; bj < 2; ++bj) { const u32x4 h = hb[ai][m][bj];
                        const f32x4 b0 = (f32x4){bf2f_lo(h.x), bf2f_hi(h.x), bf2f_lo(h.y), bf2f_hi(h.y)}, b1 = (f32x4){bf2f_lo(h.z), bf2f_hi(h.z), bf2f_lo(h.w), bf2f_hi(h.w)};
                        const f32x4 v0 = acc[ai][bj][m][0] + b0, v1 = acc[ai][bj][m][1] + b1;
                        ssq += (v0[0] * v0[0] + v0[1] * v0[1]) + (v0[2] * v0[2] + v0[3] * v0[3]) + (v1[0] * v1[0] + v1[1] * v1[1]) + (v1[2] * v1[2] + v1[3] * v1[3]);
                        u32x4 w; w.x = cvt_pk_bf16(v0[0], v0[1]); w.y = cvt_pk_bf16(v0[2], v0[3]); w.z = cvt_pk_bf16(v1[0], v1[1]); w.w = cvt_pk_bf16(v1[2], v1[3]);
                        __builtin_nontemporal_store(w, (u32x4*)(Hb + off + bj * HALF)); }
                    ssq += __shfl_xor(ssq, 16); ssq += __shfl_xor(ssq, 32);
                    if (fq == 0) red[wc * 256 + ai * HALF + wr * 64 + m * 16 + fr] = ssq; }
        }
        asm volatile("s_waitcnt lgkmcnt(0)" ::: "memory"); __builtin_amdgcn_s_barrier(); asm volatile("" ::: "memory");
        const int tid = wid * 64 + lane;
        if (tid < 256) { const float s = (red[tid] + red[256 + tid]) + (red[512 + tid] + red[768 + tid]); SS[(size_t)(u.pm * BM + tid) * 4 + u.pn] = s; }
    }
};

__device__ __forceinline__ void conv_cur2(float& u0, float& u1, float x0, float x1, float w1a, float w1b, float w0a, float w0b) {
    asm volatile("s_nop 1\n\tv_fmac_f32_dpp %0, %2, %4 row_shr:1 row_mask:0xf bank_mask:0xf bound_ctrl:1\n\tv_fmac_f32_dpp %1, %3, %5 row_shr:1 row_mask:0xf bank_mask:0xf bound_ctrl:1\n\t"
                 "v_fmac_f32_dpp %0, %2, %6 row_shr:2 row_mask:0xf bank_mask:0xf bound_ctrl:1\n\tv_fmac_f32_dpp %1, %3, %7 row_shr:2 row_mask:0xf bank_mask:0xf bound_ctrl:1"
                 : "+v"(u0), "+v"(u1) : "v"(x0), "v"(x1), "v"(w1a), "v"(w1b), "v"(w0a), "v"(w0b));
}
__device__ __forceinline__ void conv_prev2(float& u0, float& u1, float p0, float p1, float c1a, float c1b, float c2a, float c2b) {
    asm volatile("s_nop 1\n\tv_fmac_f32_dpp %0, %2, %4 row_ror:1 row_mask:0xf bank_mask:0xf\n\tv_fmac_f32_dpp %1, %3, %5 row_ror:1 row_mask:0xf bank_mask:0xf\n\t"
                 "v_fmac_f32_dpp %0, %2, %6 row_ror:2 row_mask:0xf bank_mask:0xf\n\tv_fmac_f32_dpp %1, %3, %7 row_ror:2 row_mask:0xf bank_mask:0xf"
                 : "+v"(u0), "+v"(u1) : "v"(p0), "v"(p1), "v"(c1a), "v"(c1b), "v"(c2a), "v"(c2b));
}
__device__ __forceinline__ float silu_f(float g) { return g * __builtin_amdgcn_rcpf(1.0f + __builtin_amdgcn_exp2f(-g * LOG2E)); }

struct EpiFfnUp {
    static constexpr bool PERM = true, AFTER_DRAIN = false;
    bf16_t* ACT; float* E; const float* SS; const float* cw; const float* cb;
    __device__ __forceinline__ void operator()(f32x4 (&acc)[2][2][4][2], const Unit& u, int wr, int wc, int fr_in, int fq_in, PG8_LAS unsigned char* ldsx, int ui, int wid, int lane_in) const {
        int lane = lane_in; asm volatile("" : "+v"(lane));
        const int fr = lane & 15, fq = lane >> 4; (void)fr_in; (void)fq_in;
        PG8_LAS float* H = (PG8_LAS float*)(ldsx + (ui & 1) * 12288);
        PG8_LAS float* CW = H + 2048;
        const int row0 = u.pm * BM + wr * 64 + fr; const int ct0 = wc * 32 + 8 * fq;
        float cwv0, cwv1;
        { const int t = wid * 64 + lane, c = t & 255, arr = (t >> 8) * 2; const int oc = (c >> 7) * FF + u.pn * HALF + (c & 127);
          cwv0 = arr == 0 ? cw[oc] : cw[2 * FF2 + oc]; cwv1 = arr == 0 ? cw[FF2 + oc] : cb[oc]; }
        float rs[2][4];
#pragma unroll
        for (int ai = 0; ai < 2; ++ai)
#pragma unroll
            for (int m = 0; m < 4; ++m) rs[ai][m] = row_rstd(SS, row0 + ai * HALF + m * 16);
        { const int t = wid * 64 + lane, c = t & 255, arr = (t >> 8) * 2; CW[arr * 256 + c] = cwv0; CW[(arr + 1) * 256 + c] = cwv1; }
#pragma unroll
        for (int ai = 0; ai < 2; ++ai)
#pragma unroll
            for (int m = 0; m < 4; ++m) {
#pragma unroll
                for (int bj = 0; bj < 2; ++bj)
#pragma unroll
                    for (int n = 0; n < 2; ++n) acc[ai][bj][m][n] = acc[ai][bj][m][n] * rs[ai][m];
                asm volatile("" : "+v"(acc[ai][0][m][0]), "+v"(acc[ai][0][m][1]), "+v"(acc[ai][1][m][0]), "+v"(acc[ai][1][m][1])); }
        if (fr >= 14) {
#pragma unroll
            for (int ai = 0; ai < 2; ++ai)
#pragma unroll
                for (int bj = 0; bj < 2; ++bj)
#pragma unroll
                    for (int n = 0; n < 2; ++n) *(PG8_LAS f32x4*)(H + ((2 * ai + wr) * 2 + (fr - 14)) * 256 + bj * HALF + ct0 + 4 * n) = acc[ai][bj][3][n];
        }
        { int fre = fr, cte = ct0; asm volatile("" : "+v"(fre), "+v"(cte));
          float* Ep = E + (size_t)u.pm * 4 * FF2 + (size_t)u.pn * BM + cte;
          if (wr == 0 && fre < 2) {
#pragma unroll
              for (int bj = 0; bj < 2; ++bj)
#pragma unroll
                  for (int n = 0; n < 2; ++n) *(f32x4*)(Ep + (size_t)fre * FF2 + bj * HALF + 4 * n) = acc[0][bj][0][n]; }
          if (wr == 1 && fre >= 14) {
#pragma unroll
              for (int bj = 0; bj < 2; ++bj)
#pragma unroll
                  for (int n = 0; n < 2; ++n) *(f32x4*)(Ep + (size_t)(fre - 12) * FF2 + bj * HALF + 4 * n) = acc[1][bj][3][n]; } }
        asm volatile("s_waitcnt lgkmcnt(0)" ::: "memory"); __builtin_amdgcn_s_barrier(); asm volatile("" ::: "memory");
        const int oc0 = u.pn * HALF + ct0;
#pragma unroll
        for (int bj = 0; bj < 2; ++bj)
#pragma unroll
            for (int n = 0; n < 2; ++n) {
                const int cc = bj * HALF + ct0 + 4 * n;
                const f32x4 w0 = *(const PG8_LAS f32x4*)(CW + cc), w1 = *(const PG8_LAS f32x4*)(CW + 256 + cc), w2 = *(const PG8_LAS f32x4*)(CW + 512 + cc), bb = *(const PG8_LAS f32x4*)(CW + 768 + cc);
                f32x4 c1, c2;
#pragma unroll
                for (int i = 0; i < 4; ++i) { c1[i] = fr == 0 ? w1[i] : 0.f; c2[i] = fr < 2 ? w0[i] : 0.f; }
#pragma unroll
                for (int ai = 0; ai < 2; ++ai) {
#pragma unroll
                    for (int m = 3; m >= 0; --m) {
                        const f32x4 cur = acc[ai][bj][m][n];
                        const f32x4 ui4 = w2 * cur + bb; float u0 = ui4[0], u1 = ui4[1], u2 = ui4[2], u3 = ui4[3];
                        conv_cur2(u0, u1, cur[0], cur[1], w1[0], w1[1], w0[0], w0[1]);
                        conv_cur2(u2, u3, cur[2], cur[3], w1[2], w1[3], w0[2], w0[3]);
                        if (m > 0) {
                            const f32x4 prev = acc[ai][bj][m - 1][n];
                            conv_prev2(u0, u1, prev[0], prev[1], c1[0], c1[1], c2[0], c2[1]);
                            conv_prev2(u2, u3, prev[2], prev[3], c1[2], c1[3], c2[2], c2[3]);
                        }
                        f32x4 uu = (f32x4){u0, u1, u2, u3};
                        if (m == 0) {
                            const int q = 2 * ai + wr;
                            if (q != 0) { const f32x4 h63 = *(const PG8_LAS f32x4*)(H + ((q - 1) * 2 + 1) * 256 + bj * HALF + ct0 + 4 * n), h62 = *(const PG8_LAS f32x4*)(H + ((q - 1) * 2 + 0) * 256 + bj * HALF + ct0 + 4 * n);
#pragma unroll
                                for (int i = 0; i < 4; ++i) uu[i] += c1[i] * h63[i] + c2[i] * (fr == 0 ? h62[i] : h63[i]); }
                        }
                        acc[ai][bj][m][n] = uu;
                        asm volatile("" : "+v"(acc[ai][bj][m][n]));
                        __builtin_amdgcn_sched_barrier(0);
                    }
                }
            }
#pragma unroll
        for (int ai = 0; ai < 2; ++ai)
#pragma unroll
            for (int m = 0; m < 4; ++m) { bf16_t* rowp = ACT + (size_t)(row0 + ai * HALF + m * 16) * FF + oc0;
                f32x4 a0, a1;
#pragma unroll
                for (int i = 0; i < 4; ++i) { a0[i] = silu_f(acc[ai][0][m][0][i]) * acc[ai][1][m][0][i]; a1[i] = silu_f(acc[ai][0][m][1][i]) * acc[ai][1][m][1][i]; }
                u32x4 w; w.x = cvt_pk_bf16(a0[0], a0[1]); w.y = cvt_pk_bf16(a0[2], a0[3]); w.z = cvt_pk_bf16(a1[0], a1[1]); w.w = cvt_pk_bf16(a1[2], a1[3]);
                __builtin_nontemporal_store(w, (u32x4*)rowp); }
    }
};

template <class Epi, class Sched, bool ALIGN_EPI = false, bool SP2 = false>
__device__ __forceinline__ void gemm_phase(PG8_LAS unsigned char* lds, PG8_LAS unsigned char* ldsx, const Gemm g, const Sched& S, const Epi& E) {
    int tid_ = threadIdx.x; asm volatile("" : "+v"(tid_));
    const int tid = tid_, wid = __builtin_amdgcn_readfirstlane(tid >> 6), lane = tid & 63, wr = wid >> 2, wc = wid & 3, fr = lane & 15, fq = lane >> 4;
    const int K = g.K, nt = K / BK;
    unsigned voffA[2], voffB[2];
#pragma unroll
    for (int i = 0; i < 2; ++i) { int R, C; stage_rc(tid * 16 + i * 8192, R, C); const int Rb = Epi::PERM ? ((R & ~31) + perm32(R & 31)) : R;
        voffA[i] = (unsigned)(R * K + C) * 2u; voffB[i] = (unsigned)(Rb * K + C) * 2u; }
    const size_t kstep = (size_t)(BK * 2);
    const size_t hstep = (size_t)HALF * K * 2;
    const size_t tstep = 2 * hstep;
    const unsigned ldsw = (unsigned)wid * 1024u;
    const int aoff = lds_byte(wr * 64 + fr, fq * 8), boff = lds_byte(wc * 32 + fr, fq * 8);
#define PG8_SA(b, h) (((b) * 2 + (h)) * HTB)
#define PG8_SB(b, h) ((4 + (b) * 2 + (h)) * HTB)
#define PG8_STAGE(bufoff, gbase, voff) do { _Pragma("unroll") for (int _i = 0; _i < 2; ++_i) \
        __builtin_amdgcn_global_load_lds((const unsigned*)((const char*)(gbase) + (voff)[_i]), (PG8_LAS unsigned*)(lds + (bufoff) + ldsw + _i * 8192), 16, 0, 0); } while (0)
#define PG8_LDA(dst, b, h) do { _Pragma("unroll") for (int m = 0; m < 4; ++m) _Pragma("unroll") for (int k = 0; k < 2; ++k) dst[m][k] = *(const PG8_LAS bf16x8*)(lds + PG8_SA(b, h) + aoff + m * 2048 + k * 1024); } while (0)
#define PG8_LDB(dst, b, h) do { _Pragma("unroll") for (int n = 0; n < 2; ++n) _Pragma("unroll") for (int k = 0; k < 2; ++k) dst[n][k] = *(const PG8_LAS bf16x8*)(lds + PG8_SB(b, h) + boff + n * 2048 + k * 1024); } while (0)
#define PG8_MMA(ai, bj, At, Bt) do { __builtin_amdgcn_s_setprio(1); _Pragma("unroll") for (int m = 0; m < 4; ++m) _Pragma("unroll") for (int n = 0; n < 2; ++n) _Pragma("unroll") for (int k = 0; k < 2; ++k) \
        acc[ai][bj][m][n] = __builtin_amdgcn_mfma_f32_16x16x32_bf16(Bt[n][k], At[m][k], acc[ai][bj][m][n], 0, 0, 0); __builtin_amdgcn_s_setprio(0); } while (0)
#define PG8_WAIT_V(n) asm volatile("s_waitcnt vmcnt(" #n ")" ::: "memory")
#define PG8_WAIT_L(n) asm volatile("s_waitcnt lgkmcnt(" #n ")" ::: "memory")
#define PG8_BAR __builtin_amdgcn_s_barrier()
#define PG8_SCHED __builtin_amdgcn_sched_barrier(0)
    Unit cur, nxt; int ui = 0;
    if (!S.next(0, cur)) return;
    f32x4 acc[2][2][4][2];
#pragma unroll
    for (int a = 0; a < 2; ++a)
#pragma unroll
        for (int b = 0; b < 2; ++b)
#pragma unroll
            for (int m = 0; m < 4; ++m)
#pragma unroll
                for (int n = 0; n < 2; ++n) acc[a][b][m][n] = (f32x4){0.f, 0.f, 0.f, 0.f};
    bf16x8 At[4][2], B0[2][2], B1[2][2];
    const char* cA = (const char*)g.A + (size_t)cur.pm * tstep; const char* cB = (const char*)g.Bt + (size_t)cur.pn * tstep;
    S.a_ready(cur);
    if constexpr (SP2) {
        PG8_STAGE(PG8_SB(0, 0), cB, voffB); PG8_STAGE(PG8_SB(0, 1), cB + hstep, voffB); PG8_STAGE(PG8_SA(0, 0), cA, voffA); PG8_STAGE(PG8_SA(0, 1), cA + hstep, voffA);
        if (wr == 1) PG8_BAR;
        PG8_WAIT_V(2); PG8_BAR;
        PG8_STAGE(PG8_SB(1, 0), cB + kstep, voffB); PG8_STAGE(PG8_SA(1, 0), cA + kstep, voffA); PG8_STAGE(PG8_SB(1, 1), cB + hstep + kstep, voffB);
        PG8_WAIT_V(6); PG8_BAR;
    } else {
        PG8_STAGE(PG8_SB(0, 0), cB, voffB); PG8_STAGE(PG8_SA(0, 0), cA, voffA); PG8_STAGE(PG8_SB(0, 1), cB + hstep, voffB); PG8_STAGE(PG8_SA(0, 1), cA + hstep, voffA);
        if (wr == 1) PG8_BAR;
        PG8_WAIT_V(4); PG8_BAR;
        PG8_STAGE(PG8_SB(1, 0), cB + kstep, voffB); PG8_STAGE(PG8_SA(1, 0), cA + kstep, voffA); PG8_STAGE(PG8_SB(1, 1), cB + hstep + kstep, voffB);
        PG8_WAIT_V(6); PG8_BAR;
    }
    for (;;) {
        const bool has_next = S.next(ui + 1, nxt);
        const char* nA = has_next ? (const char*)g.A + (size_t)nxt.pm * tstep : cA; const char* nB = has_next ? (const char*)g.Bt + (size_t)nxt.pn * tstep : cB;
        for (int t = 0; t < nt; t += 2) {
            const bool last = (t == nt - 2);
            const char* a1 = cA + (size_t)(t + 1) * kstep;
            const char* a2 = last ? nA : cA + (size_t)(t + 2) * kstep; const char* b2 = last ? nB : cB + (size_t)(t + 2) * kstep;
            const char* a3 = a2 + kstep; const char* b3 = b2 + kstep;
            if (last && has_next) S.a_ready(nxt);
            if constexpr (SP2) {
            PG8_LDB(B0, 0, 0); PG8_LDB(B1, 0, 1); PG8_SCHED; PG8_LDA(At, 0, 0); PG8_STAGE(PG8_SA(1, 1), a1 + hstep, voffA);
            PG8_WAIT_V(8); PG8_WAIT_L(0); PG8_BAR; PG8_MMA(0, 0, At, B0); PG8_MMA(0, 1, At, B1); PG8_BAR; PG8_SCHED;
            PG8_LDA(At, 0, 1); PG8_STAGE(PG8_SB(0, 0), b2, voffB); PG8_STAGE(PG8_SB(0, 1), b2 + hstep, voffB); PG8_STAGE(PG8_SA(0, 0), a2, voffA);
            PG8_WAIT_V(8); PG8_WAIT_L(0); PG8_BAR; PG8_MMA(1, 0, At, B0); PG8_MMA(1, 1, At, B1); PG8_BAR; PG8_SCHED;
            PG8_LDB(B0, 1, 0); PG8_LDB(B1, 1, 1); PG8_SCHED; PG8_LDA(At, 1, 0); PG8_STAGE(PG8_SA(0, 1), a2 + hstep, voffA);
            PG8_WAIT_V(8); PG8_WAIT_L(0); PG8_BAR; PG8_MMA(0, 0, At, B0); PG8_MMA(0, 1, At, B1); PG8_BAR; PG8_SCHED;
            PG8_LDA(At, 1, 1); PG8_STAGE(PG8_SB(1, 0), b3, voffB); PG8_STAGE(PG8_SB(1, 1), b3 + hstep, voffB); PG8_STAGE(PG8_SA(1, 0), a3, voffA);
            PG8_WAIT_V(8); PG8_WAIT_L(0); PG8_BAR; PG8_MMA(1, 0, At, B0); PG8_MMA(1, 1, At, B1); PG8_BAR; PG8_SCHED;
            } else {
            PG8_LDB(B0, 0, 0); PG8_SCHED; PG8_LDA(At, 0, 0); PG8_STAGE(PG8_SA(1, 1), a1 + hstep, voffA);
            PG8_WAIT_L(8); PG8_BAR; PG8_WAIT_L(0); PG8_MMA(0, 0, At, B0); PG8_BAR; PG8_SCHED;
            PG8_LDB(B1, 0, 1); PG8_STAGE(PG8_SB(0, 0), b2, voffB);
            PG8_BAR; PG8_WAIT_L(0); PG8_MMA(0, 1, At, B1); PG8_BAR;
            PG8_LDA(At, 0, 1); PG8_STAGE(PG8_SA(0, 0), a2, voffA);
            PG8_BAR; PG8_WAIT_L(0); PG8_MMA(1, 0, At, B0); PG8_BAR; PG8_SCHED;
            PG8_STAGE(PG8_SB(0, 1), b2 + hstep, voffB);
            PG8_WAIT_V(6); PG8_BAR; PG8_MMA(1, 1, At, B1); PG8_BAR;
            PG8_LDB(B0, 1, 0); PG8_SCHED; PG8_LDA(At, 1, 0); PG8_STAGE(PG8_SA(0, 1), a2 + hstep, voffA);
            PG8_WAIT_L(8); PG8_BAR; PG8_WAIT_L(0); PG8_MMA(0, 0, At, B0); PG8_BAR; PG8_SCHED;
            PG8_LDB(B1, 1, 1); PG8_STAGE(PG8_SB(1, 0), b3, voffB);
            PG8_BAR; PG8_WAIT_L(0); PG8_MMA(0, 1, At, B1); PG8_BAR;
            PG8_LDA(At, 1, 1); PG8_STAGE(PG8_SA(1, 0), a3, voffA);
            PG8_BAR; PG8_WAIT_L(0); PG8_MMA(1, 0, At, B0); PG8_BAR; PG8_SCHED;
            PG8_STAGE(PG8_SB(1, 1), b3 + hstep, voffB);
            PG8_WAIT_V(6); PG8_BAR; PG8_MMA(1, 1, At, B1); PG8_BAR;
            }
        }
        if constexpr (ALIGN_EPI) { if (wr == 0) PG8_BAR; }
        if constexpr (!Epi::AFTER_DRAIN) { E(acc, cur, wr, wc, fr, fq, ldsx, ui, wid, lane); S.done(cur); }
        if (!has_next) break;
#pragma unroll
        for (int a = 0; a < 2; ++a)
#pragma unroll
            for (int b = 0; b < 2; ++b)
#pragma unroll
                for (int m = 0; m < 4; ++m)
#pragma unroll
                    for (int n = 0; n < 2; ++n) acc[a][b][m][n] = (f32x4){0.f, 0.f, 0.f, 0.f};
        cur = nxt; cA = nA; cB = nB; ++ui;
        if constexpr (ALIGN_EPI) { if (wr == 1) PG8_BAR; }
    }
    PG8_WAIT_V(0);
    if constexpr (!ALIGN_EPI) { if (wr == 0) PG8_BAR; }
    PG8_BAR;
    if constexpr (Epi::AFTER_DRAIN) { E.fused(acc, cur, wr, wc, fr, fq, lds, wid, lane); S.done(cur); }
#undef PG8_SA
#undef PG8_SB
#undef PG8_STAGE
#undef PG8_LDA
#undef PG8_LDB
#undef PG8_MMA
#undef PG8_WAIT_V
#undef PG8_WAIT_L
#undef PG8_BAR
#undef PG8_SCHED
}
}
namespace att {
typedef __attribute__((address_space(3))) unsigned char lds_u8;
typedef unsigned short bf16_t;
typedef short bf16x8 __attribute__((ext_vector_type(8)));
typedef short v4i16 __attribute__((ext_vector_type(4)));
typedef float f32x16 __attribute__((ext_vector_type(16)));
typedef float f32x4 __attribute__((ext_vector_type(4)));
typedef unsigned u32x4 __attribute__((ext_vector_type(4)));
typedef unsigned u32x2 __attribute__((ext_vector_type(2)));
typedef float f32x2 __attribute__((ext_vector_type(2)));
#define ATT_LAS __attribute__((address_space(3)))
constexpr int KROWB = 144, NKEY = 384, LDS_K = 0, LDS_V = NKEY * KROWB  , VBLK = NKEY * 64  , LDS_BT = LDS_V + 2 * VBLK  , LDS_NT = LDS_BT + 5 * 4096  , LDS_TB = LDS_NT + 4096  , LDS_END = LDS_TB + 1024;
constexpr float NEG_BIG = -1.0e30f;
typedef __bf16 bf16x2_c __attribute__((ext_vector_type(2)));
__device__ __forceinline__ unsigned cvtpk(float lo, float hi) { const f32x2 v = {lo, hi}; const bf16x2_c b = __builtin_convertvector(v, bf16x2_c); return __builtin_bit_cast(unsigned, b); }
__device__ __forceinline__ float bf_lo(unsigned w) { return __builtin_bit_cast(float, w << 16); }
__device__ __forceinline__ float bf_hi(unsigned w) { return __builtin_bit_cast(float, w & 0xffff0000u); }
__device__ __forceinline__ int t5_bucket(int n) {
    if (n < 16) return n;
    int large = 16 + (int)(logf((float)n / 16.0f) / 4.852030263919617f * 16.0f);
    return large < 31 ? large : 31;
}
struct Unit { int b, h, dil, res, l0; };
struct Bufs { const bf16_t* Q; const bf16_t* K; const bf16_t* V; const float* rel_bias; bf16_t* Oa; bf16_t* Ob; float* STa; float* STb; bf16_t* Oout; };
struct Pre { u32x4 k[6], v[6]; };

template <bool FINAL> __device__ __forceinline__ Unit decode(int i, int G) {
    Unit u; int bh, sub;
    if (G == 256) { const int x = blockIdx.x & 7, c32 = blockIdx.x >> 3, c16 = c32 & 15; const int h = 2 * x + (c32 >> 4);
        if (FINAL) { bh = i * 16 + h; sub = c16; } else { bh = (i >> 1) * 16 + h; sub = 2 * c16 + (i & 1); } }
    else { const int uu = blockIdx.x + i * G; bh = uu & 255; sub = uu >> 8; }
    u.b = bh >> 4; u.h = bh & 15;
    if (FINAL) { u.dil = 16; u.res = sub; u.l0 = 0; }
    else if (sub < 16) { u.dil = 1; u.res = 0; u.l0 = 256 * sub; }
    else { u.dil = 4; u.res = sub & 3; u.l0 = 256 * ((sub & 15) >> 2); }
    return u;
}
template <bool FINAL> __device__ __forceinline__ int unit_count(int G) { const int total = FINAL ? 256 * 16 : 256 * 32; if (G == 256) return total / 256; return (total - (int)blockIdx.x + G - 1) / G; }
__device__ __forceinline__ void prefetch(Pre& P, const Unit& u, const Bufs& B, int tid, int wid, int q, int hi) {
    const size_t ubase = ((size_t)(u.b * NH + u.h) * SEQ + u.res) * HD; const bf16_t* Kp = B.K + ubase; const bf16_t* Vp = B.V + ubase;
    const int lsh = 6 + (u.dil == 1 ? 0 : (u.dil == 4 ? 2 : 4)), lb = u.l0 - 128;
#pragma unroll
    for (int j = 0; j < 6; ++j) { const int c = tid + 512 * j; int l = lb + (c >> 3); l = l < 0 ? 0 : l; const unsigned off = ((unsigned)l << lsh) + (unsigned)(c & 7) * 8u;
        P.k[j] = *(const u32x4*)(Kp + off); P.v[j] = *(const u32x4*)(Vp + off); }
}

template <bool FINAL>
__device__ __forceinline__ void attn_phase(lds_u8* lds, const Bufs& B) {
    int tid_ = threadIdx.x; asm volatile("" : "+v"(tid_));
    const int tid = tid_, lane = tid & 63, q = lane & 31, hi = lane >> 5; const int wid = __builtin_amdgcn_readfirstlane(tid >> 6);
    const int G = gridDim.x;
    const int nmine = unit_count<FINAL>(G); int ui = 0; if (nmine <= 0) return;
    ATT_LAS float* tb = (ATT_LAS float*)(lds + LDS_TB); ATT_LAS float* BT = (ATT_LAS float*)(lds + LDS_BT);
    Unit u = decode<FINAL>(0, G); Pre P; prefetch(P, u, B, tid, wid, q, hi);
    bf16x8 qn[4];
    if (!FINAL) { const size_t qt0 = (size_t)(u.b * NH + u.h) * SEQ + (size_t)(u.l0 + 32 * wid + q) * u.dil + u.res;
#pragma unroll
      for (int ks = 0; ks < 4; ++ks) qn[ks] = *(const bf16x8*)(B.Q + qt0 * HD + ks * 16 + hi * 8); }
    int tkey = -1;
    const int kbase = LDS_K + (32 * wid + q) * KROWB + hi * 16;
    const int g = lane >> 4, i16 = lane & 15;
    const int vbase = LDS_V + (32 * wid + 4 * (g >> 1) + (i16 >> 2)) * 64 + (16 * (g & 1) + 4 * (i16 & 3)) * 2;
    for (;;) {
        if (u.h * 32 + u.dil != tkey) { tkey = u.h * 32 + u.dil;
            if (tid < 129) tb[tid] = B.rel_bias[t5_bucket(tid * u.dil) * NH + u.h] * LOG2E;
            __syncthreads();
#pragma unroll
            for (int i = 0; i < 10; ++i) { const int idx = tid + 512 * i, j = idx & 3, ln = (idx >> 2) & 63, gq = (idx >> 8) & 3, kb = idx >> 10;
                const int delta = 128 - 32 * kb + (ln & 31) - (j + 8 * gq + 4 * (ln >> 5));
                BT[idx] = (delta >= 0 && delta <= 128) ? tb[delta < 0 ? 0 : (delta > 128 ? 128 : delta)] : NEG_BIG; }
#pragma unroll
            for (int i = 0; i < 2; ++i) BT[5 * 1024 + tid + 512 * i] = NEG_BIG; }
        const Unit cu = u; const int qpos = (cu.l0 + 32 * wid + q) * cu.dil + cu.res;
        const size_t qhm = (size_t)(cu.b * NH + cu.h) * SEQ + qpos;
        const size_t qtok = (size_t)cu.b * SEQ + qpos; const int hoff = cu.h * HD;
        bf16x8 qf[4];
#pragma unroll
        for (int ks = 0; ks < 4; ++ks) qf[ks] = FINAL ? *(const bf16x8*)(B.Q + qhm * HD + ks * 16 + hi * 8) : qn[ks];
#pragma unroll
        for (int j = 0; j < 6; ++j) { const int c = tid + 512 * j, row = c >> 3, ch = c & 7;
            *(ATT_LAS u32x4*)(lds + LDS_K + row * KROWB + ch * 16) = P.k[j];
            *(ATT_LAS u32x4*)(lds + LDS_V + (ch >> 2) * VBLK + row * 64 + (ch & 3) * 16) = P.v[j]; }
        __syncthreads();
        const bool has_next = ui + 1 < nmine;
        if (has_next) { u = decode<FINAL>(ui + 1, G); prefetch(P, u, B, tid, wid, q, hi); }
        const int kb0 = (cu.l0 == 0) ? (4 - wid > 0 ? 4 - wid : 0) : 0;
        f32x16 s[5];
#pragma unroll
        for (int kb = 0; kb < 5; ++kb) {
            if (!FINAL) {
                const int tsel = __builtin_amdgcn_readfirstlane(kb >= kb0 ? kb : 5);
#pragma unroll
                for (int gq = 0; gq < 4; ++gq) { const f32x4 t = *(const ATT_LAS f32x4*)(BT + ((tsel * 4 + gq) * 64 + lane) * 4);
                    s[kb][4 * gq] = t[0]; s[kb][4 * gq + 1] = t[1]; s[kb][4 * gq + 2] = t[2]; s[kb][4 * gq + 3] = t[3]; }
#pragma unroll
                for (int ks = 0; ks < 4; ++ks) { const bf16x8 kf = *(const ATT_LAS bf16x8*)(lds + kbase + kb * 32 * KROWB + ks * 32);
                    s[kb] = __builtin_amdgcn_mfma_f32_32x32x16_bf16(kf, qf[ks], s[kb], 0, 0, 0); }
            } else if (kb >= kb0) {
#pragma unroll
                for (int gq = 0; gq < 4; ++gq) { const f32x4 t = *(const ATT_LAS f32x4*)(BT + ((kb * 4 + gq) * 64 + lane) * 4); s[kb][4 * gq] = t[0]; s[kb][4 * gq + 1] = t[1]; s[kb][4 * gq + 2] = t[2]; s[kb][4 * gq + 3] = t[3]; }
#pragma unroll
                for (int ks = 0; ks < 4; ++ks) { const bf16x8 kf = *(const ATT_LAS bf16x8*)(lds + kbase + kb * 32 * KROWB + ks * 32);
                    s[kb] = __builtin_amdgcn_mfma_f32_32x32x16_bf16(kf, qf[ks], s[kb], 0, 0, 0); }
            } else {
#pragma unroll
                for (int r = 0; r < 16; ++r) s[kb][r] = NEG_BIG;
            }
        }
        float mx = NEG_BIG;
#pragma unroll
        for (int kb = 0; kb < 5; ++kb)
#pragma unroll
            for (int r = 0; r < 16; ++r) mx = fmaxf(mx, s[kb][r]);
        mx = fmaxf(mx, __shfl_xor(mx, 32));
        float lsum = 0.f; f32x16 o0 = {}, o1 = {};
        f32x2 st1 = {0.f, 0.f}, st2 = {0.f, 0.f}; u32x2 xa[4][2], xb[4][2];
#pragma unroll
        for (int kb = 0; kb < 5; ++kb) {
            if (!FINAL || kb >= kb0) {
#pragma unroll
                for (int r = 0; r < 16; ++r) { s[kb][r] = __builtin_amdgcn_exp2f(s[kb][r] - mx); lsum += s[kb][r]; }
                u32x4 pw0, pw1;
                pw0.x = cvtpk(s[kb][0], s[kb][1]); pw0.y = cvtpk(s[kb][2], s[kb][3]); pw0.z = cvtpk(s[kb][4], s[kb][5]); pw0.w = cvtpk(s[kb][6], s[kb][7]);
                pw1.x = cvtpk(s[kb][8], s[kb][9]); pw1.y = cvtpk(s[kb][10], s[kb][11]); pw1.z = cvtpk(s[kb][12], s[kb][13]); pw1.w = cvtpk(s[kb][14], s[kb][15]);
                const bf16x8 p0 = __builtin_bit_cast(bf16x8, pw0), p1 = __builtin_bit_cast(bf16x8, pw1);
#pragma unroll
                for (int db = 0; db < 2; ++db) {
                    const int a = vbase + db * VBLK + kb * 32 * 64;
                    const v4i16 a0 = __builtin_amdgcn_ds_read_tr16_b64_v4i16((ATT_LAS v4i16*)(lds + a));
                    const v4i16 a1 = __builtin_amdgcn_ds_read_tr16_b64_v4i16((ATT_LAS v4i16*)(lds + a + 8 * 64));
                    const v4i16 a2 = __builtin_amdgcn_ds_read_tr16_b64_v4i16((ATT_LAS v4i16*)(lds + a + 16 * 64));
                    const v4i16 a3 = __builtin_amdgcn_ds_read_tr16_b64_v4i16((ATT_LAS v4i16*)(lds + a + 24 * 64));
                    const bf16x8 v0 = (bf16x8){a0[0], a0[1], a0[2], a0[3], a1[0], a1[1], a1[2], a1[3]};
                    const bf16x8 v1 = (bf16x8){a2[0], a2[1], a2[2], a2[3], a3[0], a3[1], a3[2], a3[3]};
                    if (db == 0) { o0 = __builtin_amdgcn_mfma_f32_32x32x16_bf16(v0, p0, o0, 0, 0, 0); o0 = __builtin_amdgcn_mfma_f32_32x32x16_bf16(v1, p1, o0, 0, 0, 0); }
                    else         { o1 = __builtin_amdgcn_mfma_f32_32x32x16_bf16(v0, p0, o1, 0, 0, 0); o1 = __builtin_amdgcn_mfma_f32_32x32x16_bf16(v1, p1, o1, 0, 0, 0); }
                }
            }
            if (kb == 2) __builtin_amdgcn_sched_barrier(0);
            if (FINAL && kb == 2) {
            st1 = *(const f32x2*)(B.STa + qhm * 2); st2 = *(const f32x2*)(B.STb + qhm * 2);
            const size_t ooff = qhm * HD + 4 * hi;
#pragma unroll
            for (int gq = 0; gq < 4; ++gq)
#pragma unroll
                for (int db = 0; db < 2; ++db) { xa[gq][db] = *(const u32x2*)(B.Oa + ooff + 32 * db + 8 * gq); xb[gq][db] = *(const u32x2*)(B.Ob + ooff + 32 * db + 8 * gq); }
            }
            if (!FINAL && kb == 2 && has_next) { const size_t qt1 = (size_t)(u.b * NH + u.h) * SEQ + (size_t)(u.l0 + 32 * wid + q) * u.dil + u.res;
#pragma unroll
                for (int ks = 0; ks < 4; ++ks) qn[ks] = *(const bf16x8*)(B.Q + qt1 * HD + ks * 16 + hi * 8); }
        }
        const float l_tot = lsum + __shfl_xor(lsum, 32);
        if (!FINAL) {
            const float inv = 1.0f / l_tot;
            bf16_t* op = (cu.dil == 1 ? B.Oa : B.Ob) + qhm * HD + 4 * hi;
#pragma unroll
            for (int gq = 0; gq < 4; ++gq) {
                u32x2 w0, w1; w0.x = cvtpk(o0[4 * gq] * inv, o0[4 * gq + 1] * inv); w0.y = cvtpk(o0[4 * gq + 2] * inv, o0[4 * gq + 3] * inv);
                w1.x = cvtpk(o1[4 * gq] * inv, o1[4 * gq + 1] * inv); w1.y = cvtpk(o1[4 * gq + 2] * inv, o1[4 * gq + 3] * inv);
                *(u32x2*)(op + 8 * gq) = w0; *(u32x2*)(op + 32 + 8 * gq) = w1; }
            if (hi == 0) *(f32x2*)((cu.dil == 1 ? B.STa : B.STb) + qhm * 2) = (f32x2){mx, l_tot};
        } else {
            const f32x2 s1 = st1, s2 = st2;
            const float m_all = fmaxf(fmaxf(s1.x, s2.x), mx);
            const float e1 = s1.y * __builtin_amdgcn_exp2f(s1.x - m_all), e2 = s2.y * __builtin_amdgcn_exp2f(s2.x - m_all), e3 = __builtin_amdgcn_exp2f(mx - m_all);
            const float inv = 1.0f / (e1 + e2 + e3 * l_tot);
            const float c1 = e1 * inv, c2 = e2 * inv, c3 = e3 * inv;
            const size_t ooff = qtok * DM + hoff + 4 * hi;
#pragma unroll
            for (int gq = 0; gq < 4; ++gq) {
#pragma unroll
                for (int db = 0; db < 2; ++db) {
                    const u32x2 x1 = xa[gq][db], x2 = xb[gq][db];
                    const float a0 = db == 0 ? o0[4 * gq] : o1[4 * gq], a1 = db == 0 ? o0[4 * gq + 1] : o1[4 * gq + 1], a2 = db == 0 ? o0[4 * gq + 2] : o1[4 * gq + 2], a3 = db == 0 ? o0[4 * gq + 3] : o1[4 * gq + 3];
                    u32x2 w; w.x = cvtpk(c1 * bf_lo(x1.x) + c2 * bf_lo(x2.x) + c3 * a0, c1 * bf_hi(x1.x) + c2 * bf_hi(x2.x) + c3 * a1);
                    w.y = cvtpk(c1 * bf_lo(x1.y) + c2 * bf_lo(x2.y) + c3 * a2, c1 * bf_hi(x1.y) + c2 * bf_hi(x2.y) + c3 * a3);
                    *(u32x2*)(B.Oout + ooff + 32 * db + 8 * gq) = w; } }
        }
        __syncthreads();
        if (!has_next) break;
        ++ui;
    }
}
}

#define LAS __attribute__((address_space(3)))
typedef unsigned short bf16;
typedef unsigned v4u __attribute__((ext_vector_type(4)));
typedef unsigned v2u __attribute__((ext_vector_type(2)));
typedef float f32x4 __attribute__((ext_vector_type(4)));
constexpr int NWAVES = 8, NTHREADS = 512;
constexpr size_t MiB = 1u << 20;
constexpr size_t WS_SS = 0;
constexpr size_t WS_E = 4 * MiB;
constexpr size_t WS_ST = 28 * MiB;
constexpr size_t WS_WIN = 48 * MiB, WS_WOUT = 54 * MiB, WS_WUP0 = 56 * MiB, WS_WUP1 = 67 * MiB, WS_WD0 = 78 * MiB, WS_WD1 = 84 * MiB, WS_WQKV = 90 * MiB, WS_WO = 96 * MiB;
constexpr size_t WS_XN = 128 * MiB;
constexpr size_t WS_BIG = 256 * MiB;
constexpr size_t WS_O = 640 * MiB;
constexpr size_t WS_O2 = 768 * MiB;
constexpr size_t WS_OF = 896 * MiB;
constexpr size_t WS_END = 1024 * MiB;
constexpr int LDS_RING = 131072, LDS_X = LDS_RING, LDS_BYTES = LDS_RING + 24576;

__device__ __forceinline__ unsigned f2bf(float f) { unsigned u = __builtin_bit_cast(unsigned, f); return (u + 0x7fffu + ((u >> 16) & 1u)) >> 16; }
__device__ __forceinline__ unsigned pk2(float lo, float hi) { return f2bf(lo) | (f2bf(hi) << 16); }
__device__ __forceinline__ float bflo(unsigned w) { return __builtin_bit_cast(float, w << 16); }
__device__ __forceinline__ float bfhi(unsigned w) { return __builtin_bit_cast(float, w & 0xffff0000u); }
__device__ __forceinline__ float wave_sum(float v) {
#pragma unroll
    for (int o = 1; o < 64; o <<= 1) v += __shfl_xor(v, o);
    return v;
}
__device__ __forceinline__ void transpose_item(const float* W, int K, int N, const float* gain, bf16* WT, int k0, int n0, int drow0, LAS float* scr, int lane) {
    float wv[32];
#pragma unroll
    for (int i = 0; i < 32; ++i) wv[i] = W[(size_t)(k0 + 2 * i + (lane >> 5)) * N + n0 + (lane & 31)];
#pragma unroll
    for (int i = 0; i < 32; ++i) { const int kk = 2 * i + (lane >> 5); const float gk = gain ? gain[k0 + kk] : 1.0f; scr[kk * 33 + (lane & 31)] = wv[i] * gk; }
    asm volatile("s_waitcnt lgkmcnt(0)" ::: "memory");
    const int c = lane & 7;
#pragma unroll
    for (int j = 0; j < 4; ++j) { const int n = (lane >> 3) + 8 * j; const LAS float* s = scr + (8 * c) * 33 + n;
        v4u o; o.x = pk2(s[0 * 33], s[1 * 33]); o.y = pk2(s[2 * 33], s[3 * 33]); o.z = pk2(s[4 * 33], s[5 * 33]); o.w = pk2(s[6 * 33], s[7 * 33]);
        *(v4u*)(WT + (size_t)(drow0 + n) * K + k0 + 8 * c) = o; }
    asm volatile("s_waitcnt lgkmcnt(0)" ::: "memory");
}
template <int MODE> __device__ __forceinline__ int dest_row(int n0) {
    if (MODE == 0) return n0;
    if (MODE == 1) { if (n0 < DM) return n0; const int part = (n0 - DM) / DM  , j = (n0 - DM) % DM; return DM + (j / 128) * 256 + part * 128 + (j % 128); }
    { const int part = n0 / FF, j = n0 % FF; return (j / 128) * 256 + part * 128 + (j % 128); }
}
template <int MODE> __device__ __forceinline__ void convert_matrix(const float* W, int K, int N, const float* gain, bf16* WT, int row_off, LAS float* scr, int gw, int ngw, int lane) {
    const int nblk = N / 32, items = (K / 64) * nblk;
    for (int it = gw; it < items; it += ngw) { const int kb = it / nblk, nb = it % nblk; transpose_item(W, K, N, gain, WT, 64 * kb, 32 * nb, row_off + dest_row<MODE>(32 * nb), scr, lane); }
}

struct Args {
    const float* x; const float* a_norm; const float* a_w_in; const float* a_conv; const float* a_w_out; const float* kv_norm; const float* w_kv; const float* b_norm; const float* b_w_q; const float* b_w_o;
    const float* rel_bias; const float* ffn_norm; const float* ffn_w_up; const float* ffn_conv; const float* ffn_conv_b; const float* ffn_w_down; const float* final_norm;
    float* out; unsigned char* ws;
};

template <class Epi> __device__ __forceinline__ void run_gemm(LAS unsigned char* lds, const bf16* A, const bf16* Bt, int N, int K, const Epi& E) {
    pg8::Gemm g{A, Bt, MT, N, K}; pg8::StaticOrder S; S.init(MT, N, (int)gridDim.x, (int)blockIdx.x);
    pg8::gemm_phase<Epi, pg8::StaticOrder, true, true>(lds, lds + LDS_X, g, S, E);
}

__device__ __forceinline__ void ffn_fixup(const float* E, const float* cw, const float* cb, bf16* ACT, int gtid, int gthreads) {
    const int per = FF / 4, total = 256 * per;
    for (int it = gtid; it < total; it += gthreads) { const int pm = it / per, a = (it % per) * 4;
        if ((pm & 15) == 0) continue;
        const int pn = a >> 7, j7 = a & 127, eg = 256 * pn + j7;
        const float* Ec = E + (size_t)pm * 4 * FF2; const float* Ep = E + (size_t)(pm - 1) * 4 * FF2;
        f32x4 uu[2][2];
#pragma unroll
        for (int part = 0; part < 2; ++part) { const int e = eg + part * 128, oc = part * FF + a;
            const f32x4 w0 = *(const f32x4*)(cw + oc), w1 = *(const f32x4*)(cw + FF2 + oc), w2 = *(const f32x4*)(cw + 2 * FF2 + oc), bb = *(const f32x4*)(cb + oc);
            const f32x4 r0 = *(const f32x4*)(Ec + e), r1 = *(const f32x4*)(Ec + FF2 + e), pm2 = *(const f32x4*)(Ep + 2 * FF2 + e), pm1 = *(const f32x4*)(Ep + 3 * FF2 + e);
            uu[part][0] = w2 * r0 + w1 * pm1 + w0 * pm2 + bb; uu[part][1] = w2 * r1 + w1 * r0 + w0 * pm1 + bb; }
#pragma unroll
        for (int j = 0; j < 2; ++j) { f32x4 o;
#pragma unroll
            for (int i = 0; i < 4; ++i) o[i] = pg8::silu_f(uu[0][j][i]) * uu[1][j][i];
            v2u w; w.x = pk2(o[0], o[1]); w.y = pk2(o[2], o[3]); *(v2u*)(ACT + (size_t)(pm * 256 + j) * FF + a) = w; }
    }
}

#ifndef DUP_MASK
#define DUP_MASK 0
#endif
#define PH(k) for (int rep_ = 0; rep_ < 1 + ((DUP_MASK >> (k)) & 1); ++rep_)
#define a (*ap_)
__global__ void __launch_bounds__(NTHREADS, 2) yoco_fwd(Args a_unused) {
    extern __shared__ __attribute__((aligned(16))) unsigned char lds_raw[];
    LAS unsigned char* lds = (LAS unsigned char*)lds_raw;
    cg::grid_group grid = cg::this_grid();
    typedef const __attribute__((address_space(4))) Args* ArgsP;
    const ArgsP ap0 = (ArgsP)__builtin_amdgcn_kernarg_segment_ptr();
#define PHASE_ARGS() ArgsP ap_ = ap0; asm volatile("" : "+s"(ap_)); unsigned char* ws = ap_->ws; \
    int tid_ = threadIdx.x; asm volatile("" : "+v"(tid_)); const int tid = tid_, lane = tid & 63, wave = __builtin_amdgcn_readfirstlane(tid >> 6); \
    const int G = gridDim.x, gw = blockIdx.x * NWAVES + wave, ngw = G * NWAVES, gtid = blockIdx.x * NTHREADS + tid, gthreads = G * NTHREADS; (void)lane; (void)gw; (void)ngw; (void)gtid; (void)gthreads; \
    float* SS1 = (float*)(ws + WS_SS); float* SS2 = SS1 + 4 * MT; float* SS3 = SS2 + 4 * MT; float* SS4 = SS3 + 4 * MT; \
    float* EB = (float*)(ws + WS_E); float* ST1 = (float*)(ws + WS_ST); float* ST2 = ST1 + (size_t)MT * NH * 2; \
    bf16 *Win_t = (bf16*)(ws + WS_WIN), *Wout_t = (bf16*)(ws + WS_WOUT), *Wup0_t = (bf16*)(ws + WS_WUP0), *Wup1_t = (bf16*)(ws + WS_WUP1), *Wd0_t = (bf16*)(ws + WS_WD0), *Wd1_t = (bf16*)(ws + WS_WD1), \
         *Wqkv_t = (bf16*)(ws + WS_WQKV), *Wo_t = (bf16*)(ws + WS_WO); \
    bf16* XN = (bf16*)(ws + WS_XN); bf16* Bg = (bf16*)(ws + WS_BIG); bf16* CH = Bg + (size_t)MT * DM; bf16* Y = CH + (size_t)MT * DM; bf16* ACT = Bg; \
    bf16 *Qb = Bg, *Kb = CH, *Vb = Y; bf16* Ob = (bf16*)(ws + WS_O); bf16* O1 = Ob; bf16* O2 = (bf16*)(ws + WS_O2); bf16* OF = (bf16*)(ws + WS_OF); (void)OF; \
    (void)SS1; (void)SS2; (void)SS3; (void)SS4; (void)EB; (void)ST1; (void)ST2; (void)Win_t; (void)Wout_t; (void)Wup0_t; (void)Wup1_t; (void)Wd0_t; (void)Wd1_t; (void)Wqkv_t; (void)Wo_t; \
    (void)XN; (void)Bg; (void)CH; (void)Y; (void)ACT; (void)Qb; (void)Kb; (void)Vb; (void)Ob; (void)O1; (void)O2;

    PH(0) { PHASE_ARGS()
        LAS float* scr = (LAS float*)(lds + wave * 16384);
        convert_matrix<1>(a.a_w_in, DM, 3 * DM, nullptr, Win_t, 0, scr, gw, ngw, lane);
        convert_matrix<0>(a.a_w_out, DM, DM, nullptr, Wout_t, 0, scr, gw, ngw, lane);
        convert_matrix<2>(a.ffn_w_up, DM, FF2, a.ffn_norm, Wup0_t, 0, scr, gw, ngw, lane);
        convert_matrix<2>(a.ffn_w_up + (size_t)DM * FF2, DM, FF2, a.ffn_norm + DM, Wup1_t, 0, scr, gw, ngw, lane);
        convert_matrix<0>(a.ffn_w_down, FF, DM, nullptr, Wd0_t, 0, scr, gw, ngw, lane);
        convert_matrix<0>(a.ffn_w_down + (size_t)FF * DM, FF, DM, nullptr, Wd1_t, 0, scr, gw, ngw, lane);
        convert_matrix<0>(a.b_w_q, DM, DM, a.b_norm, Wqkv_t, 0, scr, gw, ngw, lane);
        convert_matrix<0>(a.w_kv, DM, 2 * DM, a.kv_norm, Wqkv_t, DM, scr, gw, ngw, lane);
        convert_matrix<0>(a.b_w_o, DM, DM, nullptr, Wo_t, 0, scr, gw, ngw, lane);
        for (int m = gw; m < MT; m += 2 * ngw) {
            const int m1 = m + ngw;
            const bool two = m1 < MT;
            const f32x4* xr0 = (const f32x4*)(a.x + (size_t)m * DM) + lane; const f32x4* xr1 = (const f32x4*)(a.x + (size_t)(two ? m1 : m) * DM) + lane;
            f32x4 v0[4], v1[4]; float s0 = 0.f, s1 = 0.f;
#pragma unroll
            for (int j = 0; j < 4; ++j) { v0[j] = xr0[64 * j]; v1[j] = xr1[64 * j]; }
#pragma unroll
            for (int j = 0; j < 4; ++j) { s0 += (v0[j].x * v0[j].x + v0[j].y * v0[j].y) + (v0[j].z * v0[j].z + v0[j].w * v0[j].w); s1 += (v1[j].x * v1[j].x + v1[j].y * v1[j].y) + (v1[j].z * v1[j].z + v1[j].w * v1[j].w); }
            const float r0 = __builtin_amdgcn_rsqf(wave_sum(s0) * (1.0f / DM) + RMS_EPS), r1 = __builtin_amdgcn_rsqf(wave_sum(s1) * (1.0f / DM) + RMS_EPS);
            v2u* o0 = (v2u*)(XN + (size_t)m * DM) + lane; v2u* o1 = (v2u*)(XN + (size_t)m1 * DM) + lane;
#pragma unroll
            for (int j = 0; j < 4; ++j) { const f32x4 gn = ((const f32x4*)a.a_norm)[lane + 64 * j];
                v2u w; w.x = pk2(v0[j].x * r0 * gn.x, v0[j].y * r0 * gn.y); w.y = pk2(v0[j].z * r0 * gn.z, v0[j].w * r0 * gn.w); o0[64 * j] = w;
                if (two) { v2u w1; w1.x = pk2(v1[j].x * r1 * gn.x, v1[j].y * r1 * gn.y); w1.y = pk2(v1[j].z * r1 * gn.z, v1[j].w * r1 * gn.w); o1[64 * j] = w1; } }
        }
    }
    grid.sync();
    PH(1) { PHASE_ARGS() pg8::EpiWin E{Bg, CH}; run_gemm(lds, XN, Win_t, 3 * DM, DM, E); }
    grid.sync();
    PH(2) { PHASE_ARGS()
        const int total = (MT / 8) * (DM / 8);
        const float* cw = a.a_conv;
        for (int it = gtid; it < total; it += gthreads) { const int cg8 = (it % (DM / 8)) * 8, t0 = (it / (DM / 8)) * 8;
            float w0[8], w1[8], w2[8];
#pragma unroll
            for (int i = 0; i < 8; ++i) { w0[i] = cw[cg8 + i]; w1[i] = cw[DM + cg8 + i]; w2[i] = cw[2 * DM + cg8 + i]; }
            float p2[8], p1[8];
            if ((t0 & (SEQ - 1)) == 0) {
#pragma unroll
                for (int i = 0; i < 8; ++i) { p2[i] = 0.f; p1[i] = 0.f; }
            } else { const v4u a2 = *(const v4u*)(CH + (size_t)(t0 - 2) * DM + cg8), a1 = *(const v4u*)(CH + (size_t)(t0 - 1) * DM + cg8);
                p2[0] = bflo(a2.x); p2[1] = bfhi(a2.x); p2[2] = bflo(a2.y); p2[3] = bfhi(a2.y); p2[4] = bflo(a2.z); p2[5] = bfhi(a2.z); p2[6] = bflo(a2.w); p2[7] = bfhi(a2.w);
                p1[0] = bflo(a1.x); p1[1] = bfhi(a1.x); p1[2] = bflo(a1.y); p1[3] = bfhi(a1.y); p1[4] = bflo(a1.z); p1[5] = bfhi(a1.z); p1[6] = bflo(a1.w); p1[7] = bfhi(a1.w); }
            v4u c4a[8], b4a[8];
#pragma unroll
            for (int t = 0; t < 8; ++t) { const size_t off = (size_t)(t0 + t) * DM + cg8; c4a[t] = *(const v4u*)(CH + off); b4a[t] = *(const v4u*)(Bg + off); }
#pragma unroll
            for (int t = 0; t < 8; ++t) { const size_t off = (size_t)(t0 + t) * DM + cg8; const v4u c4 = c4a[t], b4 = b4a[t];
                float c[8], bgt[8], y[8];
                c[0] = bflo(c4.x); c[1] = bfhi(c4.x); c[2] = bflo(c4.y); c[3] = bfhi(c4.y); c[4] = bflo(c4.z); c[5] = bfhi(c4.z); c[6] = bflo(c4.w); c[7] = bfhi(c4.w);
                bgt[0] = bflo(b4.x); bgt[1] = bfhi(b4.x); bgt[2] = bflo(b4.y); bgt[3] = bfhi(b4.y); bgt[4] = bflo(b4.z); bgt[5] = bfhi(b4.z); bgt[6] = bflo(b4.w); bgt[7] = bfhi(b4.w);
#pragma unroll
                for (int i = 0; i < 8; ++i) { y[i] = bgt[i] * (w2[i] * c[i] + w1[i] * p1[i] + w0[i] * p2[i]); p2[i] = p1[i]; p1[i] = c[i]; }
                v4u o; o.x = pk2(y[0], y[1]); o.y = pk2(y[2], y[3]); o.z = pk2(y[4], y[5]); o.w = pk2(y[6], y[7]); *(v4u*)(Y + off) = o; }
        }
    }
    grid.sync();
    PH(3) { PHASE_ARGS() pg8::EpiRes<true> E{a.x, XN, SS1}; run_gemm(lds, Y, Wout_t, DM, DM, E); }
    grid.sync();
    PH(4) { PHASE_ARGS() pg8::EpiFfnUp E{ACT, EB, SS1, a.ffn_conv, a.ffn_conv_b}; run_gemm(lds, XN, Wup0_t, FF2, DM, E); }
    grid.sync();
    PH(5) { PHASE_ARGS() ffn_fixup(EB, a.ffn_conv, a.ffn_conv_b, ACT, gtid, gthreads); }
    grid.sync();
    PH(6) { PHASE_ARGS() pg8::EpiRes<false> E{nullptr, XN, SS2}; run_gemm(lds, ACT, Wd0_t, DM, FF, E); }
    grid.sync();
    PH(7) { PHASE_ARGS() pg8::EpiQKV E{Qb, SS2, 0.125f * LOG2E}; run_gemm(lds, XN, Wqkv_t, 3 * DM, DM, E); }
    grid.sync();
    PH(8) { PHASE_ARGS()
        att::Bufs B{Qb, Kb, Vb, a.rel_bias, O1, O2, ST1, ST2, OF};
        att::attn_phase<false>(lds, B);
    }
    grid.sync();
    PH(9) { PHASE_ARGS()
        att::Bufs B{Qb, Kb, Vb, a.rel_bias, O1, O2, ST1, ST2, OF};
        att::attn_phase<true>(lds, B);
    }
    grid.sync();
    PH(10) { PHASE_ARGS() pg8::EpiRes<false> E{nullptr, XN, SS3}; run_gemm(lds, OF, Wo_t, DM, DM, E); }
    grid.sync();
    PH(11) { PHASE_ARGS() pg8::EpiFfnUp E{ACT, EB, SS3, a.ffn_conv + 3 * FF2, a.ffn_conv_b + FF2}; run_gemm(lds, XN, Wup1_t, FF2, DM, E); }
    grid.sync();
    PH(12) { PHASE_ARGS() ffn_fixup(EB, a.ffn_conv + 3 * FF2, a.ffn_conv_b + FF2, ACT, gtid, gthreads); }
    grid.sync();
    PH(13) { PHASE_ARGS() pg8::EpiRes<false> E{nullptr, XN, SS4}; run_gemm(lds, ACT, Wd1_t, DM, FF, E); }
    grid.sync();
    PH(14) { PHASE_ARGS() for (int m0 = gw; m0 < MT; m0 += 4 * ngw) {
        v4u hb[4][2]; float rs[4];
#pragma unroll
        for (int r = 0; r < 4; ++r) { const int m = m0 + r * ngw < MT ? m0 + r * ngw : m0; const v4u* hr = (const v4u*)(XN + (size_t)m * DM) + lane; hb[r][0] = hr[0]; hb[r][1] = hr[64]; rs[r] = pg8::row_rstd(SS4, m); }
#pragma unroll
        for (int r = 0; r < 4; ++r) { const int m = m0 + r * ngw; if (m < MT) { f32x4* xr = (f32x4*)(a.out + (size_t)m * DM);
#pragma unroll
            for (int j = 0; j < 2; ++j) { const v4u h = hb[r][j]; const int c = (lane + 64 * j) * 8; const float s = rs[r];
                const f32x4 g0 = *(const f32x4*)(a.final_norm + c), g1 = *(const f32x4*)(a.final_norm + c + 4);
                xr[(c >> 2)] = (f32x4){bflo(h.x) * s * g0.x, bfhi(h.x) * s * g0.y, bflo(h.y) * s * g0.z, bfhi(h.y) * s * g0.w};
                xr[(c >> 2) + 1] = (f32x4){bflo(h.z) * s * g1.x, bfhi(h.z) * s * g1.y, bflo(h.w) * s * g1.z, bfhi(h.w) * s * g1.w}; } } }
    } }
}

#undef a
extern "C" void kernel_launch(void* const* d_in, const int* in_sizes, int n_in, void* d_out, int out_size, void* d_ws, size_t ws_size, hipStream_t stream) {
    static int grid = 0;
    if (grid == 0) {
        if (n_in != 17 || in_sizes[0] != MT * DM || out_size != MT * DM || ws_size < WS_END) { fprintf(stderr, "kernel_launch: unexpected shapes (n_in %d, in0 %d, out %d, ws %zu)\n", n_in, n_in > 0 ? in_sizes[0] : -1, out_size, ws_size); grid = -1; return; }
        int dev = 0, cus = 0, per_cu = 0;
        hipGetDevice(&dev); hipDeviceGetAttribute(&cus, hipDeviceAttributeMultiprocessorCount, dev);
        if (hipFuncSetAttribute((const void*)yoco_fwd, hipFuncAttributeMaxDynamicSharedMemorySize, LDS_BYTES) != hipSuccess) { fprintf(stderr, "kernel_launch: hipFuncSetAttribute failed\n"); grid = -1; return; }
        if (hipOccupancyMaxActiveBlocksPerMultiprocessor(&per_cu, (const void*)yoco_fwd, NTHREADS, LDS_BYTES) != hipSuccess || per_cu < 1) { fprintf(stderr, "kernel_launch: occupancy query says %d\n", per_cu); per_cu = 1; }
        (void)hipGetLastError();
        grid = cus * 1;
    }
    if (grid < 0) return;
    Args a{};
    a.x = (const float*)d_in[0]; a.a_norm = (const float*)d_in[1]; a.a_w_in = (const float*)d_in[2]; a.a_conv = (const float*)d_in[3]; a.a_w_out = (const float*)d_in[4];
    a.kv_norm = (const float*)d_in[5]; a.w_kv = (const float*)d_in[6]; a.b_norm = (const float*)d_in[7]; a.b_w_q = (const float*)d_in[8]; a.b_w_o = (const float*)d_in[9];
    a.rel_bias = (const float*)d_in[10]; a.ffn_norm = (const float*)d_in[11]; a.ffn_w_up = (const float*)d_in[12]; a.ffn_conv = (const float*)d_in[13]; a.ffn_conv_b = (const float*)d_in[14];
    a.ffn_w_down = (const float*)d_in[15]; a.final_norm = (const float*)d_in[16];
    a.out = (float*)d_out; a.ws = (unsigned char*)d_ws;
    void* args[] = {&a};
    hipError_t e = hipLaunchCooperativeKernel((const void*)yoco_fwd, dim3(grid), dim3(NTHREADS), args, LDS_BYTES, stream);
    if (e != hipSuccess) fprintf(stderr, "cooperative launch failed: %s (grid %d)\n", hipGetErrorString(e), grid);
}
```

```cpp
#include <hip/hip_runtime.h>
#include <hip/hip_cooperative_groups.h>
#include <cstdio>
#include <cstdint>
namespace cg = cooperative_groups;

constexpr int DM = 1024, NB = 16, SEQ = 4096, MT = NB * SEQ  , NH = 16, HD = 64, FF = 2816, FF2 = 2 * FF;
constexpr float RMS_EPS = 1e-6f;
constexpr float LOG2E = 1.4426950408889634f;

namespace pg8 {
#define PG8_LAS __attribute__((address_space(3)))
typedef unsigned short bf16_t;
typedef short bf16x8 __attribute__((ext_vector_type(8)));
typedef float f32x4 __attribute__((ext_vector_type(4)));
typedef unsigned u32x4 __attribute__((ext_vector_type(4)));
constexpr int BM = 256, BK = 64, HALF = 128, HTB = HALF * BK * 2  , STAGE_BYTES = 8 * HTB, NXCD = 8, WGM = 8;

__host__ __device__ __forceinline__ int lds_byte(int r, int c) { const int st = (r >> 4) * 2 + (c >> 5), rr = r & 15, cc = c & 31, ob = rr * 64 + cc * 2; return st * 1024 + (ob ^ (((ob >> 9) & 1) << 5)); }
__host__ __device__ __forceinline__ void stage_rc(int b, int& R, int& C) { const int st = b / 1024, sb = b % 1024, swz = sb ^ (((sb >> 9) & 1) << 5); R = (st >> 1) * 16 + swz / 64; C = (st & 1) * 32 + (swz % 64) / 2; }
__host__ __device__ __forceinline__ int perm32(int rho) { const int n = rho >> 4, i = rho & 15; return 8 * (i >> 2) + 4 * n + (i & 3); }

struct Unit { int pm, pn; };
struct Gemm { const bf16_t* A; const bf16_t* Bt; int M, N, K; };

struct StaticOrder {
    int nM, nN, nwg, G, c;
    __host__ __device__ void init(int M, int N, int G_, int c_) { nM = M / BM; nN = N / BM; nwg = nM * nN; G = G_; c = c_; }
    __host__ __device__ bool next(int i, Unit& u) const {
        const long L = (long)i * G + c; if (L >= nwg) return false;
        int wgid = (int)L; { const int q = nwg / NXCD, r = nwg % NXCD, xcd = wgid % NXCD, off = wgid / NXCD; wgid = (xcd < r ? xcd * (q + 1) : r * (q + 1) + (xcd - r) * q) + off; }
        const int nig = WGM * nN, gid = wgid / nig, fm = gid * WGM, gsz = (nM - fm) < WGM ? (nM - fm) : WGM;
        u.pm = fm + ((wgid % nig) % gsz); u.pn = (wgid % nig) / gsz; return true;
    }
    __device__ __forceinline__ void a_ready(const Unit&) const {}
    __device__ __forceinline__ void done(const Unit&) const {}
};

typedef float f32x2_c __attribute__((ext_vector_type(2))); typedef __bf16 bf16x2_c __attribute__((ext_vector_type(2)));
__device__ __forceinline__ unsigned cvt_pk_bf16(float lo, float hi) { const f32x2_c v = {lo, hi}; const bf16x2_c b = __builtin_convertvector(v, bf16x2_c); return __builtin_bit_cast(unsigned, b); }
__device__ __forceinline__ float row_rstd(const float* SS, int row) {
    const f32x4 p = *(const f32x4*)(SS + (size_t)row * 4);
    const float s = (p[0] + p[1]) + (p[2] + p[3]);
    return __builtin_amdgcn_rsqf(s * (1.0f / DM) + RMS_EPS);
}
#define EPI_ARGS f32x4 (&acc)[2][2][4][2], const Unit& u, int wr, int wc, int fr, int fq, PG8_LAS unsigned char* ldsx, int ui, int wid, int lane

struct EpiWin {
    static constexpr bool PERM = true, AFTER_DRAIN = false;
    bf16_t* Bg; bf16_t* CH;
    __device__ __forceinline__ void operator()(EPI_ARGS) const {
        const int row0 = u.pm * BM + wr * 64 + fr;
        if (u.pn < 4) {
            const int col0 = u.pn * BM + wc * 32 + 8 * fq;
#pragma unroll
            for (int ai = 0; ai < 2; ++ai)
#pragma unroll
                for (int m = 0; m < 4; ++m) { bf16_t* rowp = Bg + (size_t)(row0 + ai * HALF + m * 16) * DM + col0;
#pragma unroll
                    for (int bj = 0; bj < 2; ++bj) { const f32x4 v0 = acc[ai][bj][m][0], v1 = acc[ai][bj][m][1];
                        u32x4 w; w.x = cvt_pk_bf16(v0[0], v0[1]); w.y = cvt_pk_bf16(v0[2], v0[3]); w.z = cvt_pk_bf16(v1[0], v1[1]); w.w = cvt_pk_bf16(v1[2], v1[3]);
                        __builtin_nontemporal_store(w, (u32x4*)(rowp + bj * HALF)); } }
        } else {
            const int col0 = (u.pn - 4) * HALF + wc * 32 + 8 * fq;
#pragma unroll
            for (int ai = 0; ai < 2; ++ai)
#pragma unroll
                for (int m = 0; m < 4; ++m) { bf16_t* rowp = CH + (size_t)(row0 + ai * HALF + m * 16) * DM + col0;
                    const f32x4 v0 = acc[ai][0][m][0] * acc[ai][1][m][0], v1 = acc[ai][0][m][1] * acc[ai][1][m][1];
                    u32x4 w; w.x = cvt_pk_bf16(v0[0], v0[1]); w.y = cvt_pk_bf16(v0[2], v0[3]); w.z = cvt_pk_bf16(v1[0], v1[1]); w.w = cvt_pk_bf16(v1[2], v1[3]);
                    __builtin_nontemporal_store(w, (u32x4*)rowp); }
        }
    }
};

struct EpiQKV {
    static constexpr bool PERM = true, AFTER_DRAIN = false;
    bf16_t* QKV; const float* SS; float qscale;
    __device__ __forceinline__ void operator()(EPI_ARGS) const {
        const int row0 = u.pm * BM + wr * 64 + fr; const int t = u.pn >> 2;
        bf16_t* base = QKV + (size_t)t * MT * DM; const float sc = t == 0 ? qscale : 1.0f;
        const int head0 = (u.pn & 3) * 4 + (wc >> 1), d0 = (wc & 1) * 32 + 8 * fq;
        float rsv[2][4];
#pragma unroll
        for (int ai = 0; ai < 2; ++ai)
#pragma unroll
            for (int m = 0; m < 4; ++m) rsv[ai][m] = row_rstd(SS, row0 + ai * HALF + m * 16) * sc;
#pragma unroll
        for (int ai = 0; ai < 2; ++ai)
#pragma unroll
            for (int m = 0; m < 4; ++m) { const int row = row0 + ai * HALF + m * 16; const float rs = rsv[ai][m]; const int bb = row >> 12, tt = row & (SEQ - 1);
#pragma unroll
                for (int bj = 0; bj < 2; ++bj) { const f32x4 v0 = acc[ai][bj][m][0] * rs, v1 = acc[ai][bj][m][1] * rs;
                    u32x4 w; w.x = cvt_pk_bf16(v0[0], v0[1]); w.y = cvt_pk_bf16(v0[2], v0[3]); w.z = cvt_pk_bf16(v1[0], v1[1]); w.w = cvt_pk_bf16(v1[2], v1[3]);
                    __builtin_nontemporal_store(w, (u32x4*)(base + ((size_t)(bb * NH + head0 + 2 * bj) * SEQ + tt) * HD + d0)); } }
    }
};

__device__ __forceinline__ float bf2f_lo(unsigned w) { return __builtin_bit_cast(float, w << 16); }
__device__ __forceinline__ float bf2f_hi(unsigned w) { return __builtin_bit_cast(float, w & 0xffff0000u); }
template <bool BASE_F32> struct EpiRes {
    static constexpr bool PERM = true, AFTER_DRAIN = false;
    const float* basef; bf16_t* Hb; float* SS;
    __device__ __forceinline__ void operator()(EPI_ARGS) const {
        PG8_LAS float* red = (PG8_LAS float*)(ldsx + (ui & 1) * 8192);
        const int row0 = u.pm * BM + wr * 64 + fr; const int col0 = u.pn * BM + wc * 32 + 8 * fq;
        if (BASE_F32) {
#pragma unroll
            for (int ai = 0; ai < 2; ++ai) {
                f32x4 b0[4][2], b1[4][2];
#pragma unroll
                for (int m = 0; m < 4; ++m) { const size_t off = (size_t)(row0 + ai * HALF + m * 16) * DM + col0;
#pragma unroll
                    for (int bj = 0; bj < 2; ++bj) { b0[m][bj] = *(const f32x4*)(basef + off + bj * HALF); b1[m][bj] = *(const f32x4*)(basef + off + bj * HALF + 4); } }
#pragma unroll
                for (int m = 0; m < 4; ++m) { const size_t off = (size_t)(row0 + ai * HALF + m * 16) * DM + col0; float ssq = 0.f;
#pragma unroll
                    for (int bj = 0; bj < 2; ++bj) {
                        const f32x4 v0 = acc[ai][bj][m][0] + b0[m][bj], v1 = acc[ai][bj][m][1] + b1[m][bj];
                        ssq += (v0[0] * v0[0] + v0[1] * v0[1]) + (v0[2] * v0[2] + v0[3] * v0[3]) + (v1[0] * v1[0] + v1[1] * v1[1]) + (v1[2] * v1[2] + v1[3] * v1[3]);
                        u32x4 w; w.x = cvt_pk_bf16(v0[0], v0[1]); w.y = cvt_pk_bf16(v0[2], v0[3]); w.z = cvt_pk_bf16(v1[0], v1[1]); w.w = cvt_pk_bf16(v1[2], v1[3]);
                        __builtin_nontemporal_store(w, (u32x4*)(Hb + off + bj * HALF)); }
                    ssq += __shfl_xor(ssq, 16); ssq += __shfl_xor(ssq, 32);
                    if (fq == 0) red[wc * 256 + ai * HALF + wr * 64 + m * 16 + fr] = ssq; }
            }
        } else {
            u32x4 hb[2][4][2];
#pragma unroll
            for (int ai = 0; ai < 2; ++ai)
#pragma unroll
                for (int m = 0; m < 4; ++m) { const size_t off = (size_t)(row0 + ai * HALF + m * 16) * DM + col0;
#pragma unroll
                    for (int bj = 0; bj < 2; ++bj) hb[ai][m][bj] = *(const u32x4*)(Hb + off + bj * HALF); }
#pragma unroll
            for (int ai = 0; ai < 2; ++ai)
#pragma unroll
                for (int m = 0; m < 4; ++m) { const size_t off = (size_t)(row0 + ai * HALF + m * 16) * DM + col0; float ssq = 0.f;
#pragma unroll
                    for (int bj = 0; bj < 2; ++bj) { const u32x4 h = hb[ai][m][bj];
                        const f32x4 b0 = (f32x4){bf2f_lo(h.x), bf2f_hi(h.x), bf2f_lo(h.y), bf2f_hi(h.y)}, b1 = (f32x4){bf2f_lo(h.z), bf2f_hi(h.z), bf2f_lo(h.w), bf2f_hi(h.w)};
                        const f32x4 v0 = acc[ai][bj][m][0] + b0, v1 = acc[ai][bj][m][1] + b1;
                        ssq += (v0[0] * v0[0] + v0[1] * v0[1]) + (v0[2] * v0[2] + v0[3] * v0[3]) + (v1[0] * v1[0] + v1[1] * v1[1]) + (v1[2] * v1[2] + v1[3] * v1[3]);
                        u32x4 w; w.x = cvt_pk_bf16(v0[0], v0[1]); w.y = cvt_pk_bf16(v0[2], v0[3]); w.z = cvt_pk_bf16(v1[0], v1[1]); w.w = cvt_pk_bf16(v1[2], v1[3]);
                        __builtin_nontemporal_store(w, (u32x4*)(Hb + off + bj * HALF)); }
                    ssq += __shfl_xor(ssq, 16); ssq += __shfl_xor(ssq, 32);
                    if (fq == 0) red[wc * 256 + ai * HALF + wr * 64 + m * 16 + fr] = ssq; }
        }
        asm volatile("s_waitcnt lgkmcnt(0)" ::: "memory"); __builtin_amdgcn_s_barrier(); asm volatile("" ::: "memory");
        const int tid = wid * 64 + lane;
        if (tid < 256) { const float s = (red[tid] + red[256 + tid]) + (red[512 + tid] + red[768 + tid]); SS[(size_t)(u.pm * BM + tid) * 4 + u.pn] = s; }
    }
};

__device__ __forceinline__ void conv_cur2(float& u0, float& u1, float x0, float x1, float w1a, float w1b, float w0a, float w0b) {
    asm volatile("s_nop 1\n\tv_fmac_f32_dpp %0, %2, %4 row_shr:1 row_mask:0xf bank_mask:0xf bound_ctrl:1\n\tv_fmac_f32_dpp %1, %3, %5 row_shr:1 row_mask:0xf bank_mask:0xf bound_ctrl:1\n\t"
                 "v_fmac_f32_dpp %0, %2, %6 row_shr:2 row_mask:0xf bank_mask:0xf bound_ctrl:1\n\tv_fmac_f32_dpp %1, %3, %7 row_shr:2 row_mask:0xf bank_mask:0xf bound_ctrl:1"
                 : "+v"(u0), "+v"(u1) : "v"(x0), "v"(x1), "v"(w1a), "v"(w1b), "v"(w0a), "v"(w0b));
}
__device__ __forceinline__ void conv_prev2(float& u0, float& u1, float p0, float p1, float c1a, float c1b, float c2a, float c2b) {
    asm volatile("s_nop 1\n\tv_fmac_f32_dpp %0, %2, %4 row_ror:1 row_mask:0xf bank_mask:0xf\n\tv_fmac_f32_dpp %1, %3, %5 row_ror:1 row_mask:0xf bank_mask:0xf\n\t"
                 "v_fmac_f32_dpp %0, %2, %6 row_ror:2 row_mask:0xf bank_mask:0xf\n\tv_fmac_f32_dpp %1, %3, %7 row_ror:2 row_mask:0xf bank_mask:0xf"
                 : "+v"(u0), "+v"(u1) : "v"(p0), "v"(p1), "v"(c1a), "v"(c1b), "v"(c2a), "v"(c2b));
}
__device__ __forceinline__ float silu_f(float g) { return g * __builtin_amdgcn_rcpf(1.0f + __builtin_amdgcn_exp2f(-g * LOG2E)); }

struct EpiFfnUp {
    static constexpr bool PERM = true, AFTER_DRAIN = false;
    bf16_t* ACT; float* E; const float* SS; const float* cw; const float* cb;
    __device__ __forceinline__ void operator()(f32x4 (&acc)[2][2][4][2], const Unit& u, int wr, int wc, int fr_in, int fq_in, PG8_LAS unsigned char* ldsx, int ui, int wid, int lane_in) const {
        int lane = lane_in; asm volatile("" : "+v"(lane));
        const int fr = lane & 15, fq = lane >> 4; (void)fr_in; (void)fq_in;
        PG8_LAS float* H = (PG8_LAS float*)(ldsx + (ui & 1) * 12288);
        PG8_LAS float* CW = H + 2048;
        const int row0 = u.pm * BM + wr * 64 + fr; const int ct0 = wc * 32 + 8 * fq;
        float cwv0, cwv1;
        { const int t = wid * 64 + lane, c = t & 255, arr = (t >> 8) * 2; const int oc = (c >> 7) * FF + u.pn * HALF + (c & 127);
          cwv0 = arr == 0 ? cw[oc] : cw[2 * FF2 + oc]; cwv1 = arr == 0 ? cw[FF2 + oc] : cb[oc]; }
        float rs[2][4];
#pragma unroll
        for (int ai = 0; ai < 2; ++ai)
#pragma unroll
            for (int m = 0; m < 4; ++m) rs[ai][m] = row_rstd(SS, row0 + ai * HALF + m * 16);
        { const int t = wid * 64 + lane, c = t & 255, arr = (t >> 8) * 2; CW[arr * 256 + c] = cwv0; CW[(arr + 1) * 256 + c] = cwv1; }
#pragma unroll
        for (int ai = 0; ai < 2; ++ai)
#pragma unroll
            for (int m = 0; m < 4; ++m) {
#pragma unroll
                for (int bj = 0; bj < 2; ++bj)
#pragma unroll
                    for (int n = 0; n < 2; ++n) acc[ai][bj][m][n] = acc[ai][bj][m][n] * rs[ai][m];
                asm volatile("" : "+v"(acc[ai][0][m][0]), "+v"(acc[ai][0][m][1]), "+v"(acc[ai][1][m][0]), "+v"(acc[ai][1][m][1])); }
        if (fr >= 14) {
#pragma unroll
            for (int ai = 0; ai < 2; ++ai)
#pragma unroll
                for (int bj = 0; bj < 2; ++bj)
#pragma unroll
                    for (int n = 0; n < 2; ++n) *(PG8_LAS f32x4*)(H + ((2 * ai + wr) * 2 + (fr - 14)) * 256 + bj * HALF + ct0 + 4 * n) = acc[ai][bj][3][n];
        }
        { int fre = fr, cte = ct0; asm volatile("" : "+v"(fre), "+v"(cte));
          float* Ep = E + (size_t)u.pm * 4 * FF2 + (size_t)u.pn * BM + cte;
          if (wr == 0 && fre < 2) {
#pragma unroll
              for (int bj = 0; bj < 2; ++bj)
#pragma unroll
                  for (int n = 0; n < 2; ++n) *(f32x4*)(Ep + (size_t)fre * FF2 + bj * HALF + 4 * n) = acc[0][bj][0][n]; }
          if (wr == 1 && fre >= 14) {
#pragma unroll
              for (int bj = 0; bj < 2; ++bj)
#pragma unroll
                  for (int n = 0; n < 2; ++n) *(f32x4*)(Ep + (size_t)(fre - 12) * FF2 + bj * HALF + 4 * n) = acc[1][bj][3][n]; } }
        asm volatile("s_waitcnt lgkmcnt(0)" ::: "memory"); __builtin_amdgcn_s_barrier(); asm volatile("" ::: "memory");
        const int oc0 = u.pn * HALF + ct0;
#pragma unroll
        for (int bj = 0; bj < 2; ++bj)
#pragma unroll
            for (int n = 0; n < 2; ++n) {
                const int cc = bj * HALF + ct0 + 4 * n;
                const f32x4 w0 = *(const PG8_LAS f32x4*)(CW + cc), w1 = *(const PG8_LAS f32x4*)(CW + 256 + cc), w2 = *(const PG8_LAS f32x4*)(CW + 512 + cc), bb = *(const PG8_LAS f32x4*)(CW + 768 + cc);
                f32x4 c1, c2;
#pragma unroll
                for (int i = 0; i < 4; ++i) { c1[i] = fr == 0 ? w1[i] : 0.f; c2[i] = fr < 2 ? w0[i] : 0.f; }
#pragma unroll
                for (int ai = 0; ai < 2; ++ai) {
#pragma unroll
                    for (int m = 3; m >= 0; --m) {
                        const f32x4 cur = acc[ai][bj][m][n];
                        const f32x4 ui4 = w2 * cur + bb; float u0 = ui4[0], u1 = ui4[1], u2 = ui4[2], u3 = ui4[3];
                        conv_cur2(u0, u1, cur[0], cur[1], w1[0], w1[1], w0[0], w0[1]);
                        conv_cur2(u2, u3, cur[2], cur[3], w1[2], w1[3], w0[2], w0[3]);
                        if (m > 0) {
                            const f32x4 prev = acc[ai][bj][m - 1][n];
                            conv_prev2(u0, u1, prev[0], prev[1], c1[0], c1[1], c2[0], c2[1]);
                            conv_prev2(u2, u3, prev[2], prev[3], c1[2], c1[3], c2[2], c2[3]);
                        }
                        f32x4 uu = (f32x4){u0, u1, u2, u3};
                        if (m == 0) {
                            const int q = 2 * ai + wr;
                            if (q != 0) { const f32x4 h63 = *(const PG8_LAS f32x4*)(H + ((q - 1) * 2 + 1) * 256 + bj * HALF + ct0 + 4 * n), h62 = *(const PG8_LAS f32x4*)(H + ((q - 1) * 2 + 0) * 256 + bj * HALF + ct0 + 4 * n);
#pragma unroll
                                for (int i = 0; i < 4; ++i) uu[i] += c1[i] * h63[i] + c2[i] * (fr == 0 ? h62[i] : h63[i]); }
                        }
                        acc[ai][bj][m][n] = uu;
                        asm volatile("" : "+v"(acc[ai][bj][m][n]));
                        __builtin_amdgcn_sched_barrier(0);
                    }
                }
            }
#pragma unroll
        for (int ai = 0; ai < 2; ++ai)
#pragma unroll
            for (int m = 0; m < 4; ++m) { bf16_t* rowp = ACT + (size_t)(row0 + ai * HALF + m * 16) * FF + oc0;
                f32x4 a0, a1;
#pragma unroll
                for (int i = 0; i < 4; ++i) { a0[i] = silu_f(acc[ai][0][m][0][i]) * acc[ai][1][m][0][i]; a1[i] = silu_f(acc[ai][0][m][1][i]) * acc[ai][1][m][1][i]; }
                u32x4 w; w.x = cvt_pk_bf16(a0[0], a0[1]); w.y = cvt_pk_bf16(a0[2], a0[3]); w.z = cvt_pk_bf16(a1[0], a1[1]); w.w = cvt_pk_bf16(a1[2], a1[3]);
                __builtin_nontemporal_store(w, (u32x4*)rowp); }
    }
};

template <class Epi, class Sched, bool ALIGN_EPI = false, bool SP2 = false>
__device__ __forceinline__ void gemm_phase(PG8_LAS unsigned char* lds, PG8_LAS unsigned char* ldsx, const Gemm g, const Sched& S, const Epi& E) {
    int tid_ = threadIdx.x; asm volatile("" : "+v"(tid_));
    const int tid = tid_, wid = __builtin_amdgcn_readfirstlane(tid >> 6), lane = tid & 63, wr = wid >> 2, wc = wid & 3, fr = lane & 15, fq = lane >> 4;
    const int K = g.K, nt = K / BK;
    unsigned voffA[2], voffB[2];
#pragma unroll
    for (int i = 0; i < 2; ++i) { int R, C; stage_rc(tid * 16 + i * 8192, R, C); const int Rb = Epi::PERM ? ((R & ~31) + perm32(R & 31)) : R;
        voffA[i] = (unsigned)(R * K + C) * 2u; voffB[i] = (unsigned)(Rb * K + C) * 2u; }
    const size_t kstep = (size_t)(BK * 2);
    const size_t hstep = (size_t)HALF * K * 2;
    const size_t tstep = 2 * hstep;
    const unsigned ldsw = (unsigned)wid * 1024u;
    const int aoff = lds_byte(wr * 64 + fr, fq * 8), boff = lds_byte(wc * 32 + fr, fq * 8);
#define PG8_SA(b, h) (((b) * 2 + (h)) * HTB)
#define PG8_SB(b, h) ((4 + (b) * 2 + (h)) * HTB)
#define PG8_STAGE(bufoff, gbase, voff) do { _Pragma("unroll") for (int _i = 0; _i < 2; ++_i) \
        __builtin_amdgcn_global_load_lds((const unsigned*)((const char*)(gbase) + (voff)[_i]), (PG8_LAS unsigned*)(lds + (bufoff) + ldsw + _i * 8192), 16, 0, 0); } while (0)
#define PG8_LDA(dst, b, h) do { _Pragma("unroll") for (int m = 0; m < 4; ++m) _Pragma("unroll") for (int k = 0; k < 2; ++k) dst[m][k] = *(const PG8_LAS bf16x8*)(lds + PG8_SA(b, h) + aoff + m * 2048 + k * 1024); } while (0)
#define PG8_LDB(dst, b, h) do { _Pragma("unroll") for (int n = 0; n < 2; ++n) _Pragma("unroll") for (int k = 0; k < 2; ++k) dst[n][k] = *(const PG8_LAS bf16x8*)(lds + PG8_SB(b, h) + boff + n * 2048 + k * 1024); } while (0)
#define PG8_MMA(ai, bj, At, Bt) do { __builtin_amdgcn_s_setprio(1); _Pragma("unroll") for (int m = 0; m < 4; ++m) _Pragma("unroll") for (int n = 0; n < 2; ++n) _Pragma("unroll") for (int k = 0; k < 2; ++k) \
        acc[ai][bj][m][n] = __builtin_amdgcn_mfma_f32_16x16x32_bf16(Bt[n][k], At[m][k], acc[ai][bj][m][n], 0, 0, 0); __builtin_amdgcn_s_setprio(0); } while (0)
#define PG8_WAIT_V(n) asm volatile("s_waitcnt vmcnt(" #n ")" ::: "memory")
#define PG8_WAIT_L(n) asm volatile("s_waitcnt lgkmcnt(" #n ")" ::: "memory")
#define PG8_BAR __builtin_amdgcn_s_barrier()
#define PG8_SCHED __builtin_amdgcn_sched_barrier(0)
    Unit cur, nxt; int ui = 0;
    if (!S.next(0, cur)) return;
    f32x4 acc[2][2][4][2];
#pragma unroll
    for (int a = 0; a < 2; ++a)
#pragma unroll
        for (int b = 0; b < 2; ++b)
#pragma unroll
            for (int m = 0; m < 4; ++m)
#pragma unroll
                for (int n = 0; n < 2; ++n) acc[a][b][m][n] = (f32x4){0.f, 0.f, 0.f, 0.f};
    bf16x8 At[4][2], B0[2][2], B1[2][2];
    const char* cA = (const char*)g.A + (size_t)cur.pm * tstep; const char* cB = (const char*)g.Bt + (size_t)cur.pn * tstep;
    S.a_ready(cur);
    if constexpr (SP2) {
        PG8_STAGE(PG8_SB(0, 0), cB, voffB); PG8_STAGE(PG8_SB(0, 1), cB + hstep, voffB); PG8_STAGE(PG8_SA(0, 0), cA, voffA); PG8_STAGE(PG8_SA(0, 1), cA + hstep, voffA);
        if (wr == 1) PG8_BAR;
        PG8_WAIT_V(2); PG8_BAR;
        PG8_STAGE(PG8_SB(1, 0), cB + kstep, voffB); PG8_STAGE(PG8_SA(1, 0), cA + kstep, voffA); PG8_STAGE(PG8_SB(1, 1), cB + hstep + kstep, voffB);
        PG8_WAIT_V(6); PG8_BAR;
    } else {
        PG8_STAGE(PG8_SB(0, 0), cB, voffB); PG8_STAGE(PG8_SA(0, 0), cA, voffA); PG8_STAGE(PG8_SB(0, 1), cB + hstep, voffB); PG8_STAGE(PG8_SA(0, 1), cA + hstep, voffA);
        if (wr == 1) PG8_BAR;
        PG8_WAIT_V(4); PG8_BAR;
        PG8_STAGE(PG8_SB(1, 0), cB + kstep, voffB); PG8_STAGE(PG8_SA(1, 0), cA + kstep, voffA); PG8_STAGE(PG8_SB(1, 1), cB + hstep + kstep, voffB);
        PG8_WAIT_V(6); PG8_BAR;
    }
    for (;;) {
        const bool has_next = S.next(ui + 1, nxt);
        const char* nA = has_next ? (const char*)g.A + (size_t)nxt.pm * tstep : cA; const char* nB = has_next ? (const char*)g.Bt + (size_t)nxt.pn * tstep : cB;
        for (int t = 0; t < nt; t += 2) {
            const bool last = (t == nt - 2);
            const char* a1 = cA + (size_t)(t + 1) * kstep;
            const char* a2 = last ? nA : cA + (size_t)(t + 2) * kstep; const char* b2 = last ? nB : cB + (size_t)(t + 2) * kstep;
            const char* a3 = a2 + kstep; const char* b3 = b2 + kstep;
            if (last && has_next) S.a_ready(nxt);
            if constexpr (SP2) {
            PG8_LDB(B0, 0, 0); PG8_LDB(B1, 0, 1); PG8_SCHED; PG8_LDA(At, 0, 0); PG8_STAGE(PG8_SA(1, 1), a1 + hstep, voffA);
            PG8_WAIT_V(8); PG8_WAIT_L(0); PG8_BAR; PG8_MMA(0, 0, At, B0); PG8_MMA(0, 1, At, B1); PG8_BAR; PG8_SCHED;
            PG8_LDA(At, 0, 1); PG8_STAGE(PG8_SB(0, 0), b2, voffB); PG8_STAGE(PG8_SB(0, 1), b2 + hstep, voffB); PG8_STAGE(PG8_SA(0, 0), a2, voffA);
            PG8_WAIT_V(8); PG8_WAIT_L(0); PG8_BAR; PG8_MMA(1, 0, At, B0); PG8_MMA(1, 1, At, B1); PG8_BAR; PG8_SCHED;
            PG8_LDB(B0, 1, 0); PG8_LDB(B1, 1, 1); PG8_SCHED; PG8_LDA(At, 1, 0); PG8_STAGE(PG8_SA(0, 1), a2 + hstep, voffA);
            PG8_WAIT_V(8); PG8_WAIT_L(0); PG8_BAR; PG8_MMA(0, 0, At, B0); PG8_MMA(0, 1, At, B1); PG8_BAR; PG8_SCHED;
            PG8_LDA(At, 1, 1); PG8_STAGE(PG8_SB(1, 0), b3, voffB); PG8_STAGE(PG8_SB(1, 1), b3 + hstep, voffB); PG8_STAGE(PG8_SA(1, 0), a3, voffA);
            PG8_WAIT_V(8); PG8_WAIT_L(0); PG8_BAR; PG8_MMA(1, 0, At, B0); PG8_MMA(1, 1, At, B1); PG8_BAR; PG8_SCHED;
            } else {
            PG8_LDB(B0, 0, 0); PG8_SCHED; PG8_LDA(At, 0, 0); PG8_STAGE(PG8_SA(1, 1), a1 + hstep, voffA);
            PG8_WAIT_L(8); PG8_BAR; PG8_WAIT_L(0); PG8_MMA(0, 0, At, B0); PG8_BAR; PG8_SCHED;
            PG8_LDB(B1, 0, 1); PG8_STAGE(PG8_SB(0, 0), b2, voffB);
            PG8_BAR; PG8_WAIT_L(0); PG8_MMA(0, 1, At, B1); PG8_BAR;
            PG8_LDA(At, 0, 1); PG8_STAGE(PG8_SA(0, 0), a2, voffA);
            PG8_BAR; PG8_WAIT_L(0); PG8_MMA(1, 0, At, B0); PG8_BAR; PG8_SCHED;
            PG8_STAGE(PG8_SB(0, 1), b2 + hstep, voffB);
            PG8_WAIT_V(6); PG8_BAR; PG8_MMA(1, 1, At, B1); PG8_BAR;
            PG8_LDB(B0, 1, 0); PG8_SCHED; PG8_LDA(At, 1, 0); PG8_STAGE(PG8_SA(0, 1), a2 + hstep, voffA);
            PG8_WAIT_L(8); PG8_BAR; PG8_WAIT_L(0); PG8_MMA(0, 0, At, B0); PG8_BAR; PG8_SCHED;
            PG8_LDB(B1, 1, 1); PG8_STAGE(PG8_SB(1, 0), b3, voffB);
            PG8_BAR; PG8_WAIT_L(0); PG8_MMA(0, 1, At, B1); PG8_BAR;
            PG8_LDA(At, 1, 1); PG8_STAGE(PG8_SA(1, 0), a3, voffA);
            PG8_BAR; PG8_WAIT_L(0); PG8_MMA(1, 0, At, B0); PG8_BAR; PG8_SCHED;
            PG8_STAGE(PG8_SB(1, 1), b3 + hstep, voffB);
            PG8_WAIT_V(6); PG8_BAR; PG8_MMA(1, 1, At, B1); PG8_BAR;
            }
        }
        if constexpr (ALIGN_EPI) { if (wr == 0) PG8_BAR; }
        if constexpr (!Epi::AFTER_DRAIN) { E(acc, cur, wr, wc, fr, fq, ldsx, ui, wid, lane); S.done(cur); }
        if (!has_next) break;
#pragma unroll
        for (int a = 0; a < 2; ++a)
#pragma unroll
            for (int b = 0; b < 2; ++b)
#pragma unroll
                for (int m = 0; m < 4; ++m)
#pragma unroll
                    for (int n = 0; n < 2; ++n) acc[a][b][m][n] = (f32x4){0.f, 0.f, 0.f, 0.f};
        cur = nxt; cA = nA; cB = nB; ++ui;
        if constexpr (ALIGN_EPI) { if (wr == 1) PG8_BAR; }
    }
    PG8_WAIT_V(0);
    if constexpr (!ALIGN_EPI) { if (wr == 0) PG8_BAR; }
    PG8_BAR;
    if constexpr (Epi::AFTER_DRAIN) { E.fused(acc, cur, wr, wc, fr, fq, lds, wid, lane); S.done(cur); }
#undef PG8_SA
#undef PG8_SB
#undef PG8_STAGE
#undef PG8_LDA
#undef PG8_LDB
#undef PG8_MMA
#undef PG8_WAIT_V
#undef PG8_WAIT_L
#undef PG8_BAR
#undef PG8_SCHED
}
}
namespace att {
typedef __attribute__((address_space(3))) unsigned char lds_u8;
typedef unsigned short bf16_t;
typedef short bf16x8 __attribute__((ext_vector_type(8)));
typedef short v4i16 __attribute__((ext_vector_type(4)));
typedef float f32x16 __attribute__((ext_vector_type(16)));
typedef float f32x4 __attribute__((ext_vector_type(4)));
typedef unsigned u32x4 __attribute__((ext_vector_type(4)));
typedef unsigned u32x2 __attribute__((ext_vector_type(2)));
typedef float f32x2 __attribute__((ext_vector_type(2)));
#define ATT_LAS __attribute__((address_space(3)))
constexpr int KROWB = 144, NKEY = 384, LDS_K = 0, LDS_V = NKEY * KROWB  , VBLK = NKEY * 64  , LDS_BT = LDS_V + 2 * VBLK  , LDS_NT = LDS_BT + 5 * 4096  , LDS_TB = LDS_NT + 4096  , LDS_END = LDS_TB + 1024;
constexpr float NEG_BIG = -1.0e30f;
typedef __bf16 bf16x2_c __attribute__((ext_vector_type(2)));
__device__ __forceinline__ unsigned cvtpk(float lo, float hi) { const f32x2 v = {lo, hi}; const bf16x2_c b = __builtin_convertvector(v, bf16x2_c); return __builtin_bit_cast(unsigned, b); }
__device__ __forceinline__ float bf_lo(unsigned w) { return __builtin_bit_cast(float, w << 16); }
__device__ __forceinline__ float bf_hi(unsigned w) { return __builtin_bit_cast(float, w & 0xffff0000u); }
__device__ __forceinline__ int t5_bucket(int n) {
    if (n < 16) return n;
    int large = 16 + (int)(logf((float)n / 16.0f) / 4.852030263919617f * 16.0f);
    return large < 31 ? large : 31;
}
struct Unit { int b, h, dil, res, l0; };
struct Bufs { const bf16_t* Q; const bf16_t* K; const bf16_t* V; const float* rel_bias; bf16_t* Oa; bf16_t* Ob; float* STa; float* STb; bf16_t* Oout; };
struct Pre { u32x4 k[6], v[6]; };

template <bool FINAL> __device__ __forceinline__ Unit decode(int i, int G) {
    Unit u; int bh, sub;
    if (G == 256) { const int x = blockIdx.x & 7, c32 = blockIdx.x >> 3, c16 = c32 & 15; const int h = 2 * x + (c32 >> 4);
        if (FINAL) { bh = i * 16 + h; sub = c16; } else { bh = (i >> 1) * 16 + h; sub = 2 * c16 + (i & 1); } }
    else { const int uu = blockIdx.x + i * G; bh = uu & 255; sub = uu >> 8; }
    u.b = bh >> 4; u.h = bh & 15;
    if (FINAL) { u.dil = 16; u.res = sub; u.l0 = 0; }
    else if (sub < 16) { u.dil = 1; u.res = 0; u.l0 = 256 * sub; }
    else { u.dil = 4; u.res = sub & 3; u.l0 = 256 * ((sub & 15) >> 2); }
    return u;
}
template <bool FINAL> __device__ __forceinline__ int unit_count(int G) { const int total = FINAL ? 256 * 16 : 256 * 32; if (G == 256) return total / 256; return (total - (int)blockIdx.x + G - 1) / G; }
__device__ __forceinline__ void prefetch(Pre& P, const Unit& u, const Bufs& B, int tid, int wid, int q, int hi) {
    const size_t ubase = ((size_t)(u.b * NH + u.h) * SEQ + u.res) * HD; const bf16_t* Kp = B.K + ubase; const bf16_t* Vp = B.V + ubase;
    const int lsh = 6 + (u.dil == 1 ? 0 : (u.dil == 4 ? 2 : 4)), lb = u.l0 - 128;
#pragma unroll
    for (int j = 0; j < 6; ++j) { const int c = tid + 512 * j; int l = lb + (c >> 3); l = l < 0 ? 0 : l; const unsigned off = ((unsigned)l << lsh) + (unsigned)(c & 7) * 8u;
        P.k[j] = *(const u32x4*)(Kp + off); P.v[j] = *(const u32x4*)(Vp + off); }
}

template <bool FINAL>
__device__ __forceinline__ void attn_phase(lds_u8* lds, const Bufs& B) {
    int tid_ = threadIdx.x; asm volatile("" : "+v"(tid_));
    const int tid = tid_, lane = tid & 63, q = lane & 31, hi = lane >> 5; const int wid = __builtin_amdgcn_readfirstlane(tid >> 6);
    const int G = gridDim.x;
    const int nmine = unit_count<FINAL>(G); int ui = 0; if (nmine <= 0) return;
    ATT_LAS float* tb = (ATT_LAS float*)(lds + LDS_TB); ATT_LAS float* BT = (ATT_LAS float*)(lds + LDS_BT);
    Unit u = decode<FINAL>(0, G); Pre P; prefetch(P, u, B, tid, wid, q, hi);
    bf16x8 qn[4];
    if (!FINAL) { const size_t qt0 = (size_t)(u.b * NH + u.h) * SEQ + (size_t)(u.l0 + 32 * wid + q) * u.dil + u.res;
#pragma unroll
      for (int ks = 0; ks < 4; ++ks) qn[ks] = *(const bf16x8*)(B.Q + qt0 * HD + ks * 16 + hi * 8); }
    int tkey = -1;
    const int kbase = LDS_K + (32 * wid + q) * KROWB + hi * 16;
    const int g = lane >> 4, i16 = lane & 15;
    const int vbase = LDS_V + (32 * wid + 4 * (g >> 1) + (i16 >> 2)) * 64 + (16 * (g & 1) + 4 * (i16 & 3)) * 2;
    for (;;) {
        if (u.h * 32 + u.dil != tkey) { tkey = u.h * 32 + u.dil;
            if (tid < 129) tb[tid] = B.rel_bias[t5_bucket(tid * u.dil) * NH + u.h] * LOG2E;
            __syncthreads();
#pragma unroll
            for (int i = 0; i < 10; ++i) { const int idx = tid + 512 * i, j = idx & 3, ln = (idx >> 2) & 63, gq = (idx >> 8) & 3, kb = idx >> 10;
                const int delta = 128 - 32 * kb + (ln & 31) - (j + 8 * gq + 4 * (ln >> 5));
                BT[idx] = (delta >= 0 && delta <= 128) ? tb[delta < 0 ? 0 : (delta > 128 ? 128 : delta)] : NEG_BIG; }
#pragma unroll
            for (int i = 0; i < 2; ++i) BT[5 * 1024 + tid + 512 * i] = NEG_BIG; }
        const Unit cu = u; const int qpos = (cu.l0 + 32 * wid + q) * cu.dil + cu.res;
        const size_t qhm = (size_t)(cu.b * NH + cu.h) * SEQ + qpos;
        const size_t qtok = (size_t)cu.b * SEQ + qpos; const int hoff = cu.h * HD;
        bf16x8 qf[4];
#pragma unroll
        for (int ks = 0; ks < 4; ++ks) qf[ks] = FINAL ? *(const bf16x8*)(B.Q + qhm * HD + ks * 16 + hi * 8) : qn[ks];
#pragma unroll
        for (int j = 0; j < 6; ++j) { const int c = tid + 512 * j, row = c >> 3, ch = c & 7;
            *(ATT_LAS u32x4*)(lds + LDS_K + row * KROWB + ch * 16) = P.k[j];
            *(ATT_LAS u32x4*)(lds + LDS_V + (ch >> 2) * VBLK + row * 64 + (ch & 3) * 16) = P.v[j]; }
        __syncthreads();
        const bool has_next = ui + 1 < nmine;
        if (has_next) { u = decode<FINAL>(ui + 1, G); prefetch(P, u, B, tid, wid, q, hi); }
        const int kb0 = (cu.l0 == 0) ? (4 - wid > 0 ? 4 - wid : 0) : 0;
        f32x16 s[5];
#pragma unroll
        for (int kb = 0; kb < 5; ++kb) {
            if (!FINAL) {
                const int tsel = __builtin_amdgcn_readfirstlane(kb >= kb0 ? kb : 5);
#pragma unroll
                for (int gq = 0; gq < 4; ++gq) { const f32x4 t = *(const ATT_LAS f32x4*)(BT + ((tsel * 4 + gq) * 64 + lane) * 4);
                    s[kb][4 * gq] = t[0]; s[kb][4 * gq + 1] = t[1]; s[kb][4 * gq + 2] = t[2]; s[kb][4 * gq + 3] = t[3]; }
#pragma unroll
                for (int ks = 0; ks < 4; ++ks) { const bf16x8 kf = *(const ATT_LAS bf16x8*)(lds + kbase + kb * 32 * KROWB + ks * 32);
                    s[kb] = __builtin_amdgcn_mfma_f32_32x32x16_bf16(kf, qf[ks], s[kb], 0, 0, 0); }
            } else if (kb >= kb0) {
#pragma unroll
                for (int gq = 0; gq < 4; ++gq) { const f32x4 t = *(const ATT_LAS f32x4*)(BT + ((kb * 4 + gq) * 64 + lane) * 4); s[kb][4 * gq] = t[0]; s[kb][4 * gq + 1] = t[1]; s[kb][4 * gq + 2] = t[2]; s[kb][4 * gq + 3] = t[3]; }
#pragma unroll
                for (int ks = 0; ks < 4; ++ks) { const bf16x8 kf = *(const ATT_LAS bf16x8*)(lds + kbase + kb * 32 * KROWB + ks * 32);
                    s[kb] = __builtin_amdgcn_mfma_f32_32x32x16_bf16(kf, qf[ks], s[kb], 0, 0, 0); }
            } else {
#pragma unroll
                for (int r = 0; r < 16; ++r) s[kb][r] = NEG_BIG;
            }
        }
        float mx = NEG_BIG;
#pragma unroll
        for (int kb = 0; kb < 5; ++kb)
#pragma unroll
            for (int r = 0; r < 16; ++r) mx = fmaxf(mx, s[kb][r]);
        mx = fmaxf(mx, __shfl_xor(mx, 32));
        float lsum = 0.f; f32x16 o0 = {}, o1 = {};
        f32x2 st1 = {0.f, 0.f}, st2 = {0.f, 0.f}; u32x2 xa[4][2], xb[4][2];
#pragma unroll
        for (int kb = 0; kb < 5; ++kb) {
            if (!FINAL || kb >= kb0) {
#pragma unroll
                for (int r = 0; r < 16; ++r) { s[kb][r] = __builtin_amdgcn_exp2f(s[kb][r] - mx); lsum += s[kb][r]; }
                u32x4 pw0, pw1;
                pw0.x = cvtpk(s[kb][0], s[kb][1]); pw0.y = cvtpk(s[kb][2], s[kb][3]); pw0.z = cvtpk(s[kb][4], s[kb][5]); pw0.w = cvtpk(s[kb][6], s[kb][7]);
                pw1.x = cvtpk(s[kb][8], s[kb][9]); pw1.y = cvtpk(s[kb][10], s[kb][11]); pw1.z = cvtpk(s[kb][12], s[kb][13]); pw1.w = cvtpk(s[kb][14], s[kb][15]);
                const bf16x8 p0 = __builtin_bit_cast(bf16x8, pw0), p1 = __builtin_bit_cast(bf16x8, pw1);
#pragma unroll
                for (int db = 0; db < 2; ++db) {
                    const int a = vbase + db * VBLK + kb * 32 * 64;
                    const v4i16 a0 = __builtin_amdgcn_ds_read_tr16_b64_v4i16((ATT_LAS v4i16*)(lds + a));
                    const v4i16 a1 = __builtin_amdgcn_ds_read_tr16_b64_v4i16((ATT_LAS v4i16*)(lds + a + 8 * 64));
                    const v4i16 a2 = __builtin_amdgcn_ds_read_tr16_b64_v4i16((ATT_LAS v4i16*)(lds + a + 16 * 64));
                    const v4i16 a3 = __builtin_amdgcn_ds_read_tr16_b64_v4i16((ATT_LAS v4i16*)(lds + a + 24 * 64));
                    const bf16x8 v0 = (bf16x8){a0[0], a0[1], a0[2], a0[3], a1[0], a1[1], a1[2], a1[3]};
                    const bf16x8 v1 = (bf16x8){a2[0], a2[1], a2[2], a2[3], a3[0], a3[1], a3[2], a3[3]};
                    if (db == 0) { o0 = __builtin_amdgcn_mfma_f32_32x32x16_bf16(v0, p0, o0, 0, 0, 0); o0 = __builtin_amdgcn_mfma_f32_32x32x16_bf16(v1, p1, o0, 0, 0, 0); }
                    else         { o1 = __builtin_amdgcn_mfma_f32_32x32x16_bf16(v0, p0, o1, 0, 0, 0); o1 = __builtin_amdgcn_mfma_f32_32x32x16_bf16(v1, p1, o1, 0, 0, 0); }
                }
            }
            if (kb == 2) __builtin_amdgcn_sched_barrier(0);
            if (FINAL && kb == 2) {
            st1 = *(const f32x2*)(B.STa + qhm * 2); st2 = *(const f32x2*)(B.STb + qhm * 2);
            const size_t ooff = qhm * HD + 4 * hi;
#pragma unroll
            for (int gq = 0; gq < 4; ++gq)
#pragma unroll
                for (int db = 0; db < 2; ++db) { xa[gq][db] = *(const u32x2*)(B.Oa + ooff + 32 * db + 8 * gq); xb[gq][db] = *(const u32x2*)(B.Ob + ooff + 32 * db + 8 * gq); }
            }
            if (!FINAL && kb == 2 && has_next) { const size_t qt1 = (size_t)(u.b * NH + u.h) * SEQ + (size_t)(u.l0 + 32 * wid + q) * u.dil + u.res;
#pragma unroll
                for (int ks = 0; ks < 4; ++ks) qn[ks] = *(const bf16x8*)(B.Q + qt1 * HD + ks * 16 + hi * 8); }
        }
        const float l_tot = lsum + __shfl_xor(lsum, 32);
        if (!FINAL) {
            const float inv = 1.0f / l_tot;
            bf16_t* op = (cu.dil == 1 ? B.Oa : B.Ob) + qhm * HD + 4 * hi;
#pragma unroll
            for (int gq = 0; gq < 4; ++gq) {
                u32x2 w0, w1; w0.x = cvtpk(o0[4 * gq] * inv, o0[4 * gq + 1] * inv); w0.y = cvtpk(o0[4 * gq + 2] * inv, o0[4 * gq + 3] * inv);
                w1.x = cvtpk(o1[4 * gq] * inv, o1[4 * gq + 1] * inv); w1.y = cvtpk(o1[4 * gq + 2] * inv, o1[4 * gq + 3] * inv);
                *(u32x2*)(op + 8 * gq) = w0; *(u32x2*)(op + 32 + 8 * gq) = w1; }
            if (hi == 0) *(f32x2*)((cu.dil == 1 ? B.STa : B.STb) + qhm * 2) = (f32x2){mx, l_tot};
        } else {
            const f32x2 s1 = st1, s2 = st2;
            const float m_all = fmaxf(fmaxf(s1.x, s2.x), mx);
            const float e1 = s1.y * __builtin_amdgcn_exp2f(s1.x - m_all), e2 = s2.y * __builtin_amdgcn_exp2f(s2.x - m_all), e3 = __builtin_amdgcn_exp2f(mx - m_all);
            const float inv = 1.0f / (e1 + e2 + e3 * l_tot);
            const float c1 = e1 * inv, c2 = e2 * inv, c3 = e3 * inv;
            const size_t ooff = qtok * DM + hoff + 4 * hi;
#pragma unroll
            for (int gq = 0; gq < 4; ++gq) {
#pragma unroll
                for (int db = 0; db < 2; ++db) {
                    const u32x2 x1 = xa[gq][db], x2 = xb[gq][db];
                    const float a0 = db == 0 ? o0[4 * gq] : o1[4 * gq], a1 = db == 0 ? o0[4 * gq + 1] : o1[4 * gq + 1], a2 = db == 0 ? o0[4 * gq + 2] : o1[4 * gq + 2], a3 = db == 0 ? o0[4 * gq + 3] : o1[4 * gq + 3];
                    u32x2 w; w.x = cvtpk(c1 * bf_lo(x1.x) + c2 * bf_lo(x2.x) + c3 * a0, c1 * bf_hi(x1.x) + c2 * bf_hi(x2.x) + c3 * a1);
                    w.y = cvtpk(c1 * bf_lo(x1.y) + c2 * bf_lo(x2.y) + c3 * a2, c1 * bf_hi(x1.y) + c2 * bf_hi(x2.y) + c3 * a3);
                    *(u32x2*)(B.Oout + ooff + 32 * db + 8 * gq) = w; } }
        }
        __syncthreads();
        if (!has_next) break;
        ++ui;
    }
}
}

#define LAS __attribute__((address_space(3)))
typedef unsigned short bf16;
typedef unsigned v4u __attribute__((ext_vector_type(4)));
typedef unsigned v2u __attribute__((ext_vector_type(2)));
typedef float f32x4 __attribute__((ext_vector_type(4)));
constexpr int NWAVES = 8, NTHREADS = 512;
constexpr size_t MiB = 1u << 20;
constexpr size_t WS_SS = 0;
constexpr size_t WS_E = 4 * MiB;
constexpr size_t WS_BAR = 46 * MiB, WS_BAR_BYTES = 16384;
constexpr size_t WS_ST = 28 * MiB;
constexpr size_t WS_WIN = 48 * MiB, WS_WOUT = 54 * MiB, WS_WUP0 = 56 * MiB, WS_WUP1 = 67 * MiB, WS_WD0 = 78 * MiB, WS_WD1 = 84 * MiB, WS_WQKV = 90 * MiB, WS_WO = 96 * MiB;
constexpr size_t WS_XN = 128 * MiB;
constexpr size_t WS_BIG = 256 * MiB;
constexpr size_t WS_O = 640 * MiB;
constexpr size_t WS_O2 = 768 * MiB;
constexpr size_t WS_OF = 896 * MiB;
constexpr size_t WS_END = 1024 * MiB;
constexpr int LDS_RING = 131072, LDS_X = LDS_RING, LDS_MISC = LDS_RING + 24576  , LDS_BYTES = LDS_MISC + 64;

__device__ __forceinline__ unsigned f2bf(float f) { unsigned u = __builtin_bit_cast(unsigned, f); return (u + 0x7fffu + ((u >> 16) & 1u)) >> 16; }
__device__ __forceinline__ unsigned pk2(float lo, float hi) { return f2bf(lo) | (f2bf(hi) << 16); }
__device__ __forceinline__ float bflo(unsigned w) { return __builtin_bit_cast(float, w << 16); }
__device__ __forceinline__ float bfhi(unsigned w) { return __builtin_bit_cast(float, w & 0xffff0000u); }
__device__ __forceinline__ float wave_sum(float v) {
#pragma unroll
    for (int o = 1; o < 64; o <<= 1) v += __shfl_xor(v, o);
    return v;
}
__device__ __forceinline__ void transpose_item(const float* W, int K, int N, const float* gain, bf16* WT, int k0, int n0, int drow0, LAS float* scr, int lane) {
    float wv[32];
#pragma unroll
    for (int i = 0; i < 32; ++i) wv[i] = W[(size_t)(k0 + 2 * i + (lane >> 5)) * N + n0 + (lane & 31)];
#pragma unroll
    for (int i = 0; i < 32; ++i) { const int kk = 2 * i + (lane >> 5); const float gk = gain ? gain[k0 + kk] : 1.0f; scr[kk * 33 + (lane & 31)] = wv[i] * gk; }
    asm volatile("s_waitcnt lgkmcnt(0)" ::: "memory");
    const int c = lane & 7;
#pragma unroll
    for (int j = 0; j < 4; ++j) { const int n = (lane >> 3) + 8 * j; const LAS float* s = scr + (8 * c) * 33 + n;
        v4u o; o.x = pk2(s[0 * 33], s[1 * 33]); o.y = pk2(s[2 * 33], s[3 * 33]); o.z = pk2(s[4 * 33], s[5 * 33]); o.w = pk2(s[6 * 33], s[7 * 33]);
        *(v4u*)(WT + (size_t)(drow0 + n) * K + k0 + 8 * c) = o; }
    asm volatile("s_waitcnt lgkmcnt(0)" ::: "memory");
}
template <int MODE> __device__ __forceinline__ int dest_row(int n0) {
    if (MODE == 0) return n0;
    if (MODE == 1) { if (n0 < DM) return n0; const int part = (n0 - DM) / DM  , j = (n0 - DM) % DM; return DM + (j / 128) * 256 + part * 128 + (j % 128); }
    { const int part = n0 / FF, j = n0 % FF; return (j / 128) * 256 + part * 128 + (j % 128); }
}
template <int MODE> __device__ __forceinline__ void convert_matrix(const float* W, int K, int N, const float* gain, bf16* WT, int row_off, LAS float* scr, int gw, int ngw, int lane) {
    const int nblk = N / 32, items = (K / 64) * nblk;
    for (int it = gw; it < items; it += ngw) { const int kb = it / nblk, nb = it % nblk; transpose_item(W, K, N, gain, WT, 64 * kb, 32 * nb, row_off + dest_row<MODE>(32 * nb), scr, lane); }
}

typedef unsigned v4u_unused_;
#define XB_TMO      128
#define XB_XCNT(j)  (256  + 64 * (j))
#define XB_XSUB(j)  (1280 + 64 * (j))
#define XB_XGEN(j)  (2304 + 64 * (j))
#define XB_TOP      3328
#define XB_TOPGEN   3392
#define XCD_BAR_WORDS 3456
#define XB_SPIN_CAP (1u << 18)

__device__ __forceinline__ unsigned xb_ld(unsigned* p)              { return __hip_atomic_load(p, __ATOMIC_RELAXED, __HIP_MEMORY_SCOPE_AGENT); }
__device__ __forceinline__ unsigned xb_add(unsigned* p, unsigned v) { return __hip_atomic_fetch_add(p, v, __ATOMIC_RELAXED, __HIP_MEMORY_SCOPE_AGENT); }
__device__ __forceinline__ unsigned xb_xcc_id() { return (unsigned)__builtin_amdgcn_s_getreg((3 << 11) | 20) & 0xFu; }
#define XB_SPIN(cond, bar) do { unsigned _sp = 0; while (cond) { __builtin_amdgcn_s_sleep(1); \
    if ((++_sp & 255u) == 0u) { if (xb_ld(&(bar)[XB_TMO])) break; if (_sp > XB_SPIN_CAP) { atomicAdd(&(bar)[XB_TMO], 1u); break; } } } } while (0)

struct XcdBarrier {
    unsigned* bar; unsigned x;
    volatile LAS unsigned* st;
};

__device__ __forceinline__ XcdBarrier xcd_barrier_post(unsigned* bar, volatile LAS unsigned* st) {
    XcdBarrier b; b.bar = bar; b.x = xb_xcc_id(); b.st = st;
    if (threadIdx.x == 0) (void)xb_add(&bar[XB_XCNT(b.x)], 1u);
    return b;
}
__device__ __forceinline__ void xcd_barrier_complete(unsigned* bar, unsigned x, unsigned& nloc, unsigned& nx) {
    const unsigned G = gridDim.x * gridDim.y * gridDim.z;
    unsigned sum, cnt, mine, sp = 0u;
    for (;;) {
        sum = 0u; cnt = 0u; mine = 0u;
#pragma unroll
        for (unsigned j = 0; j < 16; ++j) { const unsigned c = xb_ld(&bar[XB_XCNT(j)]); sum += c; cnt += (c > 0u) ? 1u : 0u; mine = (j == x) ? c : mine; }
        if (sum == G) break;
        __builtin_amdgcn_s_sleep(1);
        if ((++sp & 255u) == 0u) { if (xb_ld(&bar[XB_TMO])) break; if (sp > XB_SPIN_CAP) { atomicAdd(&bar[XB_TMO], 1u); break; } }
    }
    nloc = mine > 0u ? mine : 1u; nx = cnt > 0u ? cnt : 1u;
}

__device__ __forceinline__ void xcd_barrier(const XcdBarrier& b) {
    asm volatile("s_waitcnt vmcnt(0)" ::: "memory");
    __syncthreads();
    if (threadIdx.x == 0) {
        unsigned* bar = b.bar;
        __builtin_amdgcn_s_waitcnt(0);
        unsigned nloc = b.st[0], nx = b.st[1];
        if (nloc == 0u) { xcd_barrier_complete(bar, b.x, nloc, nx); b.st[0] = nloc; b.st[1] = nx; }
        const unsigned old = xb_add(&bar[XB_XSUB(b.x)], 1u);
        const unsigned gen = old / nloc;
        if (old + 1u == (gen + 1u) * nloc) {
            __builtin_amdgcn_fence(__ATOMIC_RELEASE, "agent");
            asm volatile("s_waitcnt vmcnt(0)" ::: "memory");
            const unsigned og = xb_add(&bar[XB_TOP], 1u);
            const unsigned tg = og / nx;
            if (og + 1u == (tg + 1u) * nx) xb_add(&bar[XB_TOPGEN], 1u);
            else XB_SPIN(xb_ld(&bar[XB_TOPGEN]) == tg, bar);
            __builtin_amdgcn_fence(__ATOMIC_ACQUIRE, "agent");
            xb_add(&bar[XB_XGEN(b.x)], 1u);
            asm volatile("s_waitcnt vmcnt(0)" ::: "memory");
        } else {
            XB_SPIN(xb_ld(&bar[XB_XGEN(b.x)]) == gen, bar);
            __builtin_amdgcn_fence(__ATOMIC_ACQUIRE, "agent");
            asm volatile("s_waitcnt vmcnt(0)" ::: "memory");
        }
    }
    __syncthreads();
}

struct Args {
    const float* x; const float* a_norm; const float* a_w_in; const float* a_conv; const float* a_w_out; const float* kv_norm; const float* w_kv; const float* b_norm; const float* b_w_q; const float* b_w_o;
    const float* rel_bias; const float* ffn_norm; const float* ffn_w_up; const float* ffn_conv; const float* ffn_conv_b; const float* ffn_w_down; const float* final_norm;
    float* out; unsigned char* ws;
};

template <class Epi> __device__ __forceinline__ void run_gemm(LAS unsigned char* lds, const bf16* A, const bf16* Bt, int N, int K, const Epi& E) {
    pg8::Gemm g{A, Bt, MT, N, K}; pg8::StaticOrder S; S.init(MT, N, (int)gridDim.x, (int)blockIdx.x);
    pg8::gemm_phase<Epi, pg8::StaticOrder, true, true>(lds, lds + LDS_X, g, S, E);
}

__device__ __forceinline__ void ffn_fixup(const float* E, const float* cw, const float* cb, bf16* ACT, int gtid, int gthreads) {
    const int per = FF / 4, total = 256 * per;
    for (int it = gtid; it < total; it += gthreads) { const int pm = it / per, a = (it % per) * 4;
        if ((pm & 15) == 0) continue;
        const int pn = a >> 7, j7 = a & 127, eg = 256 * pn + j7;
        const float* Ec = E + (size_t)pm * 4 * FF2; const float* Ep = E + (size_t)(pm - 1) * 4 * FF2;
        f32x4 uu[2][2];
#pragma unroll
        for (int part = 0; part < 2; ++part) { const int e = eg + part * 128, oc = part * FF + a;
            const f32x4 w0 = *(const f32x4*)(cw + oc), w1 = *(const f32x4*)(cw + FF2 + oc), w2 = *(const f32x4*)(cw + 2 * FF2 + oc), bb = *(const f32x4*)(cb + oc);
            const f32x4 r0 = *(const f32x4*)(Ec + e), r1 = *(const f32x4*)(Ec + FF2 + e), pm2 = *(const f32x4*)(Ep + 2 * FF2 + e), pm1 = *(const f32x4*)(Ep + 3 * FF2 + e);
            uu[part][0] = w2 * r0 + w1 * pm1 + w0 * pm2 + bb; uu[part][1] = w2 * r1 + w1 * r0 + w0 * pm1 + bb; }
#pragma unroll
        for (int j = 0; j < 2; ++j) { f32x4 o;
#pragma unroll
            for (int i = 0; i < 4; ++i) o[i] = pg8::silu_f(uu[0][j][i]) * uu[1][j][i];
            v2u w; w.x = pk2(o[0], o[1]); w.y = pk2(o[2], o[3]); *(v2u*)(ACT + (size_t)(pm * 256 + j) * FF + a) = w; }
    }
}

#ifndef DUP_MASK
#define DUP_MASK 0
#endif
#define PH(k) for (int rep_ = 0; rep_ < 1 + ((DUP_MASK >> (k)) & 1); ++rep_)
#define a (*ap_)
__global__ void __launch_bounds__(NTHREADS, 2) yoco_fwd(Args a_unused) {
    extern __shared__ __attribute__((aligned(16))) unsigned char lds_raw[];
    LAS unsigned char* lds = (LAS unsigned char*)lds_raw;
    cg::grid_group grid = cg::this_grid();
    volatile LAS unsigned* MISC = (volatile LAS unsigned*)(lds + LDS_MISC);
    if (threadIdx.x < 2) MISC[threadIdx.x] = 0u;
    __syncthreads();
    typedef const __attribute__((address_space(4))) Args* ArgsP;
    const ArgsP ap0 = (ArgsP)__builtin_amdgcn_kernarg_segment_ptr();
    (void)xcd_barrier_post((unsigned*)(ap0->ws + WS_BAR), MISC);
#define GRID_BAR() do { XcdBarrier b_; b_.bar = (unsigned*)(ap0->ws + WS_BAR); b_.x = xb_xcc_id(); b_.st = MISC; xcd_barrier(b_); } while (0)
#define PHASE_ARGS() ArgsP ap_ = ap0; asm volatile("" : "+s"(ap_)); unsigned char* ws = ap_->ws; \
    int tid_ = threadIdx.x; asm volatile("" : "+v"(tid_)); const int tid = tid_, lane = tid & 63, wave = __builtin_amdgcn_readfirstlane(tid >> 6); \
    const int G = gridDim.x, gw = blockIdx.x * NWAVES + wave, ngw = G * NWAVES, gtid = blockIdx.x * NTHREADS + tid, gthreads = G * NTHREADS; (void)lane; (void)gw; (void)ngw; (void)gtid; (void)gthreads; \
    float* SS1 = (float*)(ws + WS_SS); float* SS2 = SS1 + 4 * MT; float* SS3 = SS2 + 4 * MT; float* SS4 = SS3 + 4 * MT; \
    float* EB = (float*)(ws + WS_E); float* ST1 = (float*)(ws + WS_ST); float* ST2 = ST1 + (size_t)MT * NH * 2; \
    bf16 *Win_t = (bf16*)(ws + WS_WIN), *Wout_t = (bf16*)(ws + WS_WOUT), *Wup0_t = (bf16*)(ws + WS_WUP0), *Wup1_t = (bf16*)(ws + WS_WUP1), *Wd0_t = (bf16*)(ws + WS_WD0), *Wd1_t = (bf16*)(ws + WS_WD1), \
         *Wqkv_t = (bf16*)(ws + WS_WQKV), *Wo_t = (bf16*)(ws + WS_WO); \
    bf16* XN = (bf16*)(ws + WS_XN); bf16* Bg = (bf16*)(ws + WS_BIG); bf16* CH = Bg + (size_t)MT * DM; bf16* Y = CH + (size_t)MT * DM; bf16* ACT = Bg; \
    bf16 *Qb = Bg, *Kb = CH, *Vb = Y; bf16* Ob = (bf16*)(ws + WS_O); bf16* O1 = Ob; bf16* O2 = (bf16*)(ws + WS_O2); bf16* OF = (bf16*)(ws + WS_OF); (void)OF; \
    (void)SS1; (void)SS2; (void)SS3; (void)SS4; (void)EB; (void)ST1; (void)ST2; (void)Win_t; (void)Wout_t; (void)Wup0_t; (void)Wup1_t; (void)Wd0_t; (void)Wd1_t; (void)Wqkv_t; (void)Wo_t; \
    (void)XN; (void)Bg; (void)CH; (void)Y; (void)ACT; (void)Qb; (void)Kb; (void)Vb; (void)Ob; (void)O1; (void)O2;

    PH(0) { PHASE_ARGS()
        LAS float* scr = (LAS float*)(lds + wave * 16384);
        convert_matrix<1>(a.a_w_in, DM, 3 * DM, nullptr, Win_t, 0, scr, gw, ngw, lane);
        convert_matrix<0>(a.a_w_out, DM, DM, nullptr, Wout_t, 0, scr, gw, ngw, lane);
        convert_matrix<2>(a.ffn_w_up, DM, FF2, a.ffn_norm, Wup0_t, 0, scr, gw, ngw, lane);
        convert_matrix<2>(a.ffn_w_up + (size_t)DM * FF2, DM, FF2, a.ffn_norm + DM, Wup1_t, 0, scr, gw, ngw, lane);
        convert_matrix<0>(a.ffn_w_down, FF, DM, nullptr, Wd0_t, 0, scr, gw, ngw, lane);
        convert_matrix<0>(a.ffn_w_down + (size_t)FF * DM, FF, DM, nullptr, Wd1_t, 0, scr, gw, ngw, lane);
        convert_matrix<0>(a.b_w_q, DM, DM, a.b_norm, Wqkv_t, 0, scr, gw, ngw, lane);
        convert_matrix<0>(a.w_kv, DM, 2 * DM, a.kv_norm, Wqkv_t, DM, scr, gw, ngw, lane);
        convert_matrix<0>(a.b_w_o, DM, DM, nullptr, Wo_t, 0, scr, gw, ngw, lane);
        for (int m = gw; m < MT; m += 2 * ngw) {
            const int m1 = m + ngw;
            const bool two = m1 < MT;
            const f32x4* xr0 = (const f32x4*)(a.x + (size_t)m * DM) + lane; const f32x4* xr1 = (const f32x4*)(a.x + (size_t)(two ? m1 : m) * DM) + lane;
            f32x4 v0[4], v1[4]; float s0 = 0.f, s1 = 0.f;
#pragma unroll
            for (int j = 0; j < 4; ++j) { v0[j] = xr0[64 * j]; v1[j] = xr1[64 * j]; }
#pragma unroll
            for (int j = 0; j < 4; ++j) { s0 += (v0[j].x * v0[j].x + v0[j].y * v0[j].y) + (v0[j].z * v0[j].z + v0[j].w * v0[j].w); s1 += (v1[j].x * v1[j].x + v1[j].y * v1[j].y) + (v1[j].z * v1[j].z + v1[j].w * v1[j].w); }
            const float r0 = __builtin_amdgcn_rsqf(wave_sum(s0) * (1.0f / DM) + RMS_EPS), r1 = __builtin_amdgcn_rsqf(wave_sum(s1) * (1.0f / DM) + RMS_EPS);
            v2u* o0 = (v2u*)(XN + (size_t)m * DM) + lane; v2u* o1 = (v2u*)(XN + (size_t)m1 * DM) + lane;
#pragma unroll
            for (int j = 0; j < 4; ++j) { const f32x4 gn = ((const f32x4*)a.a_norm)[lane + 64 * j];
                v2u w; w.x = pk2(v0[j].x * r0 * gn.x, v0[j].y * r0 * gn.y); w.y = pk2(v0[j].z * r0 * gn.z, v0[j].w * r0 * gn.w); o0[64 * j] = w;
                if (two) { v2u w1; w1.x = pk2(v1[j].x * r1 * gn.x, v1[j].y * r1 * gn.y); w1.y = pk2(v1[j].z * r1 * gn.z, v1[j].w * r1 * gn.w); o1[64 * j] = w1; } }
        }
    }
    grid.sync();
    PH(1) { PHASE_ARGS() pg8::EpiWin E{Bg, CH}; run_gemm(lds, XN, Win_t, 3 * DM, DM, E); }
    GRID_BAR();
    PH(2) { PHASE_ARGS()
        const int total = (MT / 8) * (DM / 8);
        const float* cw = a.a_conv;
        for (int it = gtid; it < total; it += gthreads) { const int cg8 = (it % (DM / 8)) * 8, t0 = (it / (DM / 8)) * 8;
            float w0[8], w1[8], w2[8];
#pragma unroll
            for (int i = 0; i < 8; ++i) { w0[i] = cw[cg8 + i]; w1[i] = cw[DM + cg8 + i]; w2[i] = cw[2 * DM + cg8 + i]; }
            float p2[8], p1[8];
            if ((t0 & (SEQ - 1)) == 0) {
#pragma unroll
                for (int i = 0; i < 8; ++i) { p2[i] = 0.f; p1[i] = 0.f; }
            } else { const v4u a2 = *(const v4u*)(CH + (size_t)(t0 - 2) * DM + cg8), a1 = *(const v4u*)(CH + (size_t)(t0 - 1) * DM + cg8);
                p2[0] = bflo(a2.x); p2[1] = bfhi(a2.x); p2[2] = bflo(a2.y); p2[3] = bfhi(a2.y); p2[4] = bflo(a2.z); p2[5] = bfhi(a2.z); p2[6] = bflo(a2.w); p2[7] = bfhi(a2.w);
                p1[0] = bflo(a1.x); p1[1] = bfhi(a1.x); p1[2] = bflo(a1.y); p1[3] = bfhi(a1.y); p1[4] = bflo(a1.z); p1[5] = bfhi(a1.z); p1[6] = bflo(a1.w); p1[7] = bfhi(a1.w); }
            v4u c4a[8], b4a[8];
#pragma unroll
            for (int t = 0; t < 8; ++t) { const size_t off = (size_t)(t0 + t) * DM + cg8; c4a[t] = *(const v4u*)(CH + off); b4a[t] = *(const v4u*)(Bg + off); }
#pragma unroll
            for (int t = 0; t < 8; ++t) { const size_t off = (size_t)(t0 + t) * DM + cg8; const v4u c4 = c4a[t], b4 = b4a[t];
                float c[8], bgt[8], y[8];
                c[0] = bflo(c4.x); c[1] = bfhi(c4.x); c[2] = bflo(c4.y); c[3] = bfhi(c4.y); c[4] = bflo(c4.z); c[5] = bfhi(c4.z); c[6] = bflo(c4.w); c[7] = bfhi(c4.w);
                bgt[0] = bflo(b4.x); bgt[1] = bfhi(b4.x); bgt[2] = bflo(b4.y); bgt[3] = bfhi(b4.y); bgt[4] = bflo(b4.z); bgt[5] = bfhi(b4.z); bgt[6] = bflo(b4.w); bgt[7] = bfhi(b4.w);
#pragma unroll
                for (int i = 0; i < 8; ++i) { y[i] = bgt[i] * (w2[i] * c[i] + w1[i] * p1[i] + w0[i] * p2[i]); p2[i] = p1[i]; p1[i] = c[i]; }
                v4u o; o.x = pk2(y[0], y[1]); o.y = pk2(y[2], y[3]); o.z = pk2(y[4], y[5]); o.w = pk2(y[6], y[7]); *(v4u*)(Y + off) = o; }
        }
    }
    GRID_BAR();
    PH(3) { PHASE_ARGS() pg8::EpiRes<true> E{a.x, XN, SS1}; run_gemm(lds, Y, Wout_t, DM, DM, E); }
    GRID_BAR();
    PH(4) { PHASE_ARGS() pg8::EpiFfnUp E{ACT, EB, SS1, a.ffn_conv, a.ffn_conv_b}; run_gemm(lds, XN, Wup0_t, FF2, DM, E); }
    GRID_BAR();
    PH(5) { PHASE_ARGS() ffn_fixup(EB, a.ffn_conv, a.ffn_conv_b, ACT, gtid, gthreads); }
    GRID_BAR();
    PH(6) { PHASE_ARGS() pg8::EpiRes<false> E{nullptr, XN, SS2}; run_gemm(lds, ACT, Wd0_t, DM, FF, E); }
    GRID_BAR();
    PH(7) { PHASE_ARGS() pg8::EpiQKV E{Qb, SS2, 0.125f * LOG2E}; run_gemm(lds, XN, Wqkv_t, 3 * DM, DM, E); }
    GRID_BAR();
    PH(8) { PHASE_ARGS()
        att::Bufs B{Qb, Kb, Vb, a.rel_bias, O1, O2, ST1, ST2, OF};
        att::attn_phase<false>(lds, B);
    }
    GRID_BAR();
    PH(9) { PHASE_ARGS()
        att::Bufs B{Qb, Kb, Vb, a.rel_bias, O1, O2, ST1, ST2, OF};
        att::attn_phase<true>(lds, B);
    }
    GRID_BAR();
    PH(10) { PHASE_ARGS() pg8::EpiRes<false> E{nullptr, XN, SS3}; run_gemm(lds, OF, Wo_t, DM, DM, E); }
    GRID_BAR();
    PH(11) { PHASE_ARGS() pg8::EpiFfnUp E{ACT, EB, SS3, a.ffn_conv + 3 * FF2, a.ffn_conv_b + FF2}; run_gemm(lds, XN, Wup1_t, FF2, DM, E); }
    GRID_BAR();
    PH(12) { PHASE_ARGS() ffn_fixup(EB, a.ffn_conv + 3 * FF2, a.ffn_conv_b + FF2, ACT, gtid, gthreads); }
    GRID_BAR();
    PH(13) { PHASE_ARGS() pg8::EpiRes<false> E{nullptr, XN, SS4}; run_gemm(lds, ACT, Wd1_t, DM, FF, E); }
    GRID_BAR();
    PH(14) { PHASE_ARGS() for (int m0 = gw; m0 < MT; m0 += 4 * ngw) {
        v4u hb[4][2]; float rs[4];
#pragma unroll
        for (int r = 0; r < 4; ++r) { const int m = m0 + r * ngw < MT ? m0 + r * ngw : m0; const v4u* hr = (const v4u*)(XN + (size_t)m * DM) + lane; hb[r][0] = hr[0]; hb[r][1] = hr[64]; rs[r] = pg8::row_rstd(SS4, m); }
#pragma unroll
        for (int r = 0; r < 4; ++r) { const int m = m0 + r * ngw; if (m < MT) { f32x4* xr = (f32x4*)(a.out + (size_t)m * DM);
#pragma unroll
            for (int j = 0; j < 2; ++j) { const v4u h = hb[r][j]; const int c = (lane + 64 * j) * 8; const float s = rs[r];
                const f32x4 g0 = *(const f32x4*)(a.final_norm + c), g1 = *(const f32x4*)(a.final_norm + c + 4);
                xr[(c >> 2)] = (f32x4){bflo(h.x) * s * g0.x, bfhi(h.x) * s * g0.y, bflo(h.y) * s * g0.z, bfhi(h.y) * s * g0.w};
                xr[(c >> 2) + 1] = (f32x4){bflo(h.z) * s * g1.x, bfhi(h.z) * s * g1.y, bflo(h.w) * s * g1.z, bfhi(h.w) * s * g1.w}; } } }
    } }
}

#undef a
extern "C" void kernel_launch(void* const* d_in, const int* in_sizes, int n_in, void* d_out, int out_size, void* d_ws, size_t ws_size, hipStream_t stream) {
    static int grid = 0;
    if (grid == 0) {
        if (n_in != 17 || in_sizes[0] != MT * DM || out_size != MT * DM || ws_size < WS_END) { fprintf(stderr, "kernel_launch: unexpected shapes (n_in %d, in0 %d, out %d, ws %zu)\n", n_in, n_in > 0 ? in_sizes[0] : -1, out_size, ws_size); grid = -1; return; }
        int dev = 0, cus = 0, per_cu = 0;
        hipGetDevice(&dev); hipDeviceGetAttribute(&cus, hipDeviceAttributeMultiprocessorCount, dev);
        if (hipFuncSetAttribute((const void*)yoco_fwd, hipFuncAttributeMaxDynamicSharedMemorySize, LDS_BYTES) != hipSuccess) { fprintf(stderr, "kernel_launch: hipFuncSetAttribute failed\n"); grid = -1; return; }
        if (hipOccupancyMaxActiveBlocksPerMultiprocessor(&per_cu, (const void*)yoco_fwd, NTHREADS, LDS_BYTES) != hipSuccess || per_cu < 1) { fprintf(stderr, "kernel_launch: occupancy query says %d\n", per_cu); per_cu = 1; }
        (void)hipGetLastError();
        grid = cus * 1;
    }
    if (grid < 0) return;
    Args a{};
    a.x = (const float*)d_in[0]; a.a_norm = (const float*)d_in[1]; a.a_w_in = (const float*)d_in[2]; a.a_conv = (const float*)d_in[3]; a.a_w_out = (const float*)d_in[4];
    a.kv_norm = (const float*)d_in[5]; a.w_kv = (const float*)d_in[6]; a.b_norm = (const float*)d_in[7]; a.b_w_q = (const float*)d_in[8]; a.b_w_o = (const float*)d_in[9];
    a.rel_bias = (const float*)d_in[10]; a.ffn_norm = (const float*)d_in[11]; a.ffn_w_up = (const float*)d_in[12]; a.ffn_conv = (const float*)d_in[13]; a.ffn_conv_b = (const float*)d_in[14];
    a.ffn_w_down = (const float*)d_in[15]; a.final_norm = (const float*)d_in[16];
    a.out = (float*)d_out; a.ws = (unsigned char*)d_ws;
    if (hipMemsetAsync((char*)d_ws + WS_BAR, 0, WS_BAR_BYTES, stream) != hipSuccess) { fprintf(stderr, "kernel_launch: memset of the barrier words failed\n"); return; }
    void* args[] = {&a};
    hipError_t e = hipLaunchCooperativeKernel((const void*)yoco_fwd, dim3(grid), dim3(NTHREADS), args, LDS_BYTES, stream);
    if (e != hipSuccess) fprintf(stderr, "cooperative launch failed: %s (grid %d)\n", hipGetErrorString(e), grid);
}
```

```cpp
#include <hip/hip_runtime.h>
#include <hip/hip_cooperative_groups.h>
#include <cstdio>
#include <cstdint>
namespace cg = cooperative_groups;

constexpr int DM = 1024, NB = 16, SEQ = 4096, MT = NB * SEQ  , NH = 16, HD = 64, FF = 2816, FF2 = 2 * FF;
constexpr float RMS_EPS = 1e-6f;
constexpr float LOG2E = 1.4426950408889634f;

namespace pg8 {
#define PG8_LAS __attribute__((address_space(3)))
typedef unsigned short bf16_t;
typedef short bf16x8 __attribute__((ext_vector_type(8)));
typedef float f32x4 __attribute__((ext_vector_type(4)));
typedef unsigned u32x4 __attribute__((ext_vector_type(4)));
constexpr int BM = 256, BK = 64, HALF = 128, HTB = HALF * BK * 2  , STAGE_BYTES = 8 * HTB, NXCD = 8, WGM = 8;

__host__ __device__ __forceinline__ int lds_byte(int r, int c) { const int st = (r >> 4) * 2 + (c >> 5), rr = r & 15, cc = c & 31, ob = rr * 64 + cc * 2; return st * 1024 + (ob ^ (((ob >> 9) & 1) << 5)); }
__host__ __device__ __forceinline__ void stage_rc(int b, int& R, int& C) { const int st = b / 1024, sb = b % 1024, swz = sb ^ (((sb >> 9) & 1) << 5); R = (st >> 1) * 16 + swz / 64; C = (st & 1) * 32 + (swz % 64) / 2; }
__host__ __device__ __forceinline__ int perm32(int rho) { const int n = rho >> 4, i = rho & 15; return 8 * (i >> 2) + 4 * n + (i & 3); }

struct Unit { int pm, pn; };
struct Gemm { const bf16_t* A; const bf16_t* Bt; int M, N, K; };

struct StaticOrder {
    int nM, nN, nwg, G, c;
    __host__ __device__ void init(int M, int N, int G_, int c_) { nM = M / BM; nN = N / BM; nwg = nM * nN; G = G_; c = c_; }
    __host__ __device__ bool next(int i, Unit& u) const {
        const long L = (long)i * G + c; if (L >= nwg) return false;
        int wgid = (int)L; { const int q = nwg / NXCD, r = nwg % NXCD, xcd = wgid % NXCD, off = wgid / NXCD; wgid = (xcd < r ? xcd * (q + 1) : r * (q + 1) + (xcd - r) * q) + off; }
        const int nig = WGM * nN, gid = wgid / nig, fm = gid * WGM, gsz = (nM - fm) < WGM ? (nM - fm) : WGM;
        u.pm = fm + ((wgid % nig) % gsz); u.pn = (wgid % nig) / gsz; return true;
    }
    __device__ __forceinline__ void a_ready(const Unit&) const {}
    __device__ __forceinline__ void done(const Unit&) const {}
};

typedef float f32x2_c __attribute__((ext_vector_type(2))); typedef __bf16 bf16x2_c __attribute__((ext_vector_type(2)));
__device__ __forceinline__ unsigned cvt_pk_bf16(float lo, float hi) { const f32x2_c v = {lo, hi}; const bf16x2_c b = __builtin_convertvector(v, bf16x2_c); return __builtin_bit_cast(unsigned, b); }
__device__ __forceinline__ float row_rstd(const float* SS, int row) {
    const f32x4 p = *(const f32x4*)(SS + (size_t)row * 4);
    const float s = (p[0] + p[1]) + (p[2] + p[3]);
    return __builtin_amdgcn_rsqf(s * (1.0f / DM) + RMS_EPS);
}
#define EPI_ARGS f32x4 (&acc)[2][2][4][2], const Unit& u, int wr, int wc, int fr, int fq, PG8_LAS unsigned char* ldsx, int ui, int wid, int lane

struct EpiWin {
    static constexpr bool PERM = true, AFTER_DRAIN = false;
    bf16_t* Bg; bf16_t* CH;
    __device__ __forceinline__ void operator()(EPI_ARGS) const {
        const int row0 = u.pm * BM + wr * 64 + fr;
        if (u.pn < 4) {
            const int col0 = u.pn * BM + wc * 32 + 8 * fq;
#pragma unroll
            for (int ai = 0; ai < 2; ++ai)
#pragma unroll
                for (int m = 0; m < 4; ++m) { bf16_t* rowp = Bg + (size_t)(row0 + ai * HALF + m * 16) * DM + col0;
#pragma unroll
                    for (int bj = 0; bj < 2; ++bj) { const f32x4 v0 = acc[ai][bj][m][0], v1 = acc[ai][bj][m][1];
                        u32x4 w; w.x = cvt_pk_bf16(v0[0], v0[1]); w.y = cvt_pk_bf16(v0[2], v0[3]); w.z = cvt_pk_bf16(v1[0], v1[1]); w.w = cvt_pk_bf16(v1[2], v1[3]);
                        __builtin_nontemporal_store(w, (u32x4*)(rowp + bj * HALF)); } }
        } else {
            const int col0 = (u.pn - 4) * HALF + wc * 32 + 8 * fq;
#pragma unroll
            for (int ai = 0; ai < 2; ++ai)
#pragma unroll
                for (int m = 0; m < 4; ++m) { bf16_t* rowp = CH + (size_t)(row0 + ai * HALF + m * 16) * DM + col0;
                    const f32x4 v0 = acc[ai][0][m][0] * acc[ai][1][m][0], v1 = acc[ai][0][m][1] * acc[ai][1][m][1];
                    u32x4 w; w.x = cvt_pk_bf16(v0[0], v0[1]); w.y = cvt_pk_bf16(v0[2], v0[3]); w.z = cvt_pk_bf16(v1[0], v1[1]); w.w = cvt_pk_bf16(v1[2], v1[3]);
                    __builtin_nontemporal_store(w, (u32x4*)rowp); }
        }
    }
};

struct EpiQKV {
    static constexpr bool PERM = true, AFTER_DRAIN = false;
    bf16_t* QKV; const float* SS; float qscale;
    __device__ __forceinline__ void operator()(EPI_ARGS) const {
        const int row0 = u.pm * BM + wr * 64 + fr; const int t = u.pn >> 2;
        bf16_t* base = QKV + (size_t)t * MT * DM; const float sc = t == 0 ? qscale : 1.0f;
        const int head0 = (u.pn & 3) * 4 + (wc >> 1), d0 = (wc & 1) * 32 + 8 * fq;
        float rsv[2][4];
#pragma unroll
        for (int ai = 0; ai < 2; ++ai)
#pragma unroll
            for (int m = 0; m < 4; ++m) rsv[ai][m] = row_rstd(SS, row0 + ai * HALF + m * 16) * sc;
#pragma unroll
        for (int ai = 0; ai < 2; ++ai)
#pragma unroll
            for (int m = 0; m < 4; ++m) { const int row = row0 + ai * HALF + m * 16; const float rs = rsv[ai][m]; const int bb = row >> 12, tt = row & (SEQ - 1);
#pragma unroll
                for (int bj = 0; bj < 2; ++bj) { const f32x4 v0 = acc[ai][bj][m][0] * rs, v1 = acc[ai][bj][m][1] * rs;
                    u32x4 w; w.x = cvt_pk_bf16(v0[0], v0[1]); w.y = cvt_pk_bf16(v0[2], v0[3]); w.z = cvt_pk_bf16(v1[0], v1[1]); w.w = cvt_pk_bf16(v1[2], v1[3]);
                    __builtin_nontemporal_store(w, (u32x4*)(base + ((size_t)(bb * NH + head0 + 2 * bj) * SEQ + tt) * HD + d0)); } }
    }
};

__device__ __forceinline__ float bf2f_lo(unsigned w) { return __builtin_bit_cast(float, w << 16); }
__device__ __forceinline__ float bf2f_hi(unsigned w) { return __builtin_bit_cast(float, w & 0xffff0000u); }
template <bool BASE_F32> struct EpiRes {
    static constexpr bool PERM = true, AFTER_DRAIN = false;
    const float* basef; bf16_t* Hb; float* SS;
    __device__ __forceinline__ void operator()(EPI_ARGS) const {
        PG8_LAS float* red = (PG8_LAS float*)(ldsx + (ui & 1) * 8192);
        const int row0 = u.pm * BM + wr * 64 + fr; const int col0 = u.pn * BM + wc * 32 + 8 * fq;
        if (BASE_F32) {
#pragma unroll
            for (int ai = 0; ai < 2; ++ai) {
                f32x4 b0[4][2], b1[4][2];
#pragma unroll
                for (int m = 0; m < 4; ++m) { const size_t off = (size_t)(row0 + ai * HALF + m * 16) * DM + col0;
#pragma unroll
                    for (int bj = 0; bj < 2; ++bj) { b0[m][bj] = *(const f32x4*)(basef + off + bj * HALF); b1[m][bj] = *(const f32x4*)(basef + off + bj * HALF + 4); } }
#pragma unroll
                for (int m = 0; m < 4; ++m) { const size_t off = (size_t)(row0 + ai * HALF + m * 16) * DM + col0; float ssq = 0.f;
#pragma unroll
                    for (int bj = 0; bj < 2; ++bj) {
                        const f32x4 v0 = acc[ai][bj][m][0] + b0[m][bj], v1 = acc[ai][bj][m][1] + b1[m][bj];
                        ssq += (v0[0] * v0[0] + v0[1] * v0[1]) + (v0[2] * v0[2] + v0[3] * v0[3]) + (v1[0] * v1[0] + v1[1] * v1[1]) + (v1[2] * v1[2] + v1[3] * v1[3]);
                        u32x4 w; w.x = cvt_pk_bf16(v0[0], v0[1]); w.y = cvt_pk_bf16(v0[2], v0[3]); w.z = cvt_pk_bf16(v1[0], v1[1]); w.w = cvt_pk_bf16(v1[2], v1[3]);
                        __builtin_nontemporal_store(w, (u32x4*)(Hb + off + bj * HALF)); }
                    ssq += __shfl_xor(ssq, 16); ssq += __shfl_xor(ssq, 32);
                    if (fq == 0) red[wc * 256 + ai * HALF + wr * 64 + m * 16 + fr] = ssq; }
            }
        } else {
            u32x4 hb[2][4][2];
#pragma unroll
            for (int ai = 0; ai < 2; ++ai)
#pragma unroll
                for (int m = 0; m < 4; ++m) { const size_t off = (size_t)(row0 + ai * HALF + m * 16) * DM + col0;
#pragma unroll
                    for (int bj = 0; bj < 2; ++bj) hb[ai][m][bj] = *(const u32x4*)(Hb + off + bj * HALF); }
#pragma unroll
            for (int ai = 0; ai < 2; ++ai)
#pragma unroll
                for (int m = 0; m < 4; ++m) { const size_t off = (size_t)(row0 + ai * HALF + m * 16) * DM + col0; float ssq = 0.f;
#pragma unroll
                    for (int bj = 0; bj < 2; ++bj) { const u32x4 h = hb[ai][m][bj];
                        const f32x4 b0 = (f32x4){bf2f_lo(h.x), bf2f_hi(h.x), bf2f_lo(h.y), bf2f_hi(h.y)}, b1 = (f32x4){bf2f_lo(h.z), bf2f_hi(h.z), bf2f_lo(h.w), bf2f_hi(h.w)};
                        const f32x4 v0 = acc[ai][bj][m][0] + b0, v1 = acc[ai][bj][m][1] + b1;
                        ssq += (v0[0] * v0[0] + v0[1] * v0[1]) + (v0[2] * v0[2] + v0[3] * v0[3]) + (v1[0] * v1[0] + v1[1] * v1[1]) + (v1[2] * v1[2] + v1[3] * v1[3]);
                        u32x4 w; w.x = cvt_pk_bf16(v0[0], v0[1]); w.y = cvt_pk_bf16(v0[2], v0[3]); w.z = cvt_pk_bf16(v1[0], v1[1]); w.w = cvt_pk_bf16(v1[2], v1[3]);
                        __builtin_nontemporal_store(w, (u32x4*)(Hb + off + bj * HALF)); }
                    ssq += __shfl_xor(ssq, 16); ssq += __shfl_xor(ssq, 32);
                    if (fq == 0) red[wc * 256 + ai * HALF + wr * 64 + m * 16 + fr] = ssq; }
        }
        asm volatile("s_waitcnt lgkmcnt(0)" ::: "memory"); __builtin_amdgcn_s_barrier(); asm volatile("" ::: "memory");
        const int tid = wid * 64 + lane;
        if (tid < 256) { const float s = (red[tid] + red[256 + tid]) + (red[512 + tid] + red[768 + tid]); SS[(size_t)(u.pm * BM + tid) * 4 + u.pn] = s; }
    }
};

__device__ __forceinline__ void conv_cur2(float& u0, float& u1, float x0, float x1, float w1a, float w1b, float w0a, float w0b) {
    asm volatile("s_nop 1\n\tv_fmac_f32_dpp %0, %2, %4 row_shr:1 row_mask:0xf bank_mask:0xf bound_ctrl:1\n\tv_fmac_f32_dpp %1, %3, %5 row_shr:1 row_mask:0xf bank_mask:0xf bound_ctrl:1\n\t"
                 "v_fmac_f32_dpp %0, %2, %6 row_shr:2 row_mask:0xf bank_mask:0xf bound_ctrl:1\n\tv_fmac_f32_dpp %1, %3, %7 row_shr:2 row_mask:0xf bank_mask:0xf bound_ctrl:1"
                 : "+v"(u0), "+v"(u1) : "v"(x0), "v"(x1), "v"(w1a), "v"(w1b), "v"(w0a), "v"(w0b));
}
__device__ __forceinline__ void conv_prev2(float& u0, float& u1, float p0, float p1, float c1a, float c1b, float c2a, float c2b) {
    asm volatile("s_nop 1\n\tv_fmac_f32_dpp %0, %2, %4 row_ror:1 row_mask:0xf bank_mask:0xf\n\tv_fmac_f32_dpp %1, %3, %5 row_ror:1 row_mask:0xf bank_mask:0xf\n\t"
                 "v_fmac_f32_dpp %0, %2, %6 row_ror:2 row_mask:0xf bank_mask:0xf\n\tv_fmac_f32_dpp %1, %3, %7 row_ror:2 row_mask:0xf bank_mask:0xf"
                 : "+v"(u0), "+v"(u1) : "v"(p0), "v"(p1), "v"(c1a), "v"(c1b), "v"(c2a), "v"(c2b));
}
__device__ __forceinline__ float silu_f(float g) { return g * __builtin_amdgcn_rcpf(1.0f + __builtin_amdgcn_exp2f(-g * LOG2E)); }

struct EpiFfnUp {
    static constexpr bool PERM = true, AFTER_DRAIN = false;
    bf16_t* ACT; float* E; const float* SS; const float* cw; const float* cb;
    __device__ __forceinline__ void operator()(f32x4 (&acc)[2][2][4][2], const Unit& u, int wr, int wc, int fr_in, int fq_in, PG8_LAS unsigned char* ldsx, int ui, int wid, int lane_in) const {
        int lane = lane_in; asm volatile("" : "+v"(lane));
        const int fr = lane & 15, fq = lane >> 4; (void)fr_in; (void)fq_in;
        PG8_LAS float* H = (PG8_LAS float*)(ldsx + (ui & 1) * 12288);
        PG8_LAS float* CW = H + 2048;
        const int row0 = u.pm * BM + wr * 64 + fr; const int ct0 = wc * 32 + 8 * fq;
        float cwv0, cwv1;
        { const int t = wid * 64 + lane, c = t & 255, arr = (t >> 8) * 2; const int oc = (c >> 7) * FF + u.pn * HALF + (c & 127);
          cwv0 = arr == 0 ? cw[oc] : cw[2 * FF2 + oc]; cwv1 = arr == 0 ? cw[FF2 + oc] : cb[oc]; }
        float rs[2][4];
#pragma unroll
        for (int ai = 0; ai < 2; ++ai)
#pragma unroll
            for (int m = 0; m < 4; ++m) rs[ai][m] = row_rstd(SS, row0 + ai * HALF + m * 16);
        { const int t = wid * 64 + lane, c = t & 255, arr = (t >> 8) * 2; CW[arr * 256 + c] = cwv0; CW[(arr + 1) * 256 + c] = cwv1; }
#pragma unroll
        for (int ai = 0; ai < 2; ++ai)
#pragma unroll
            for (int m = 0; m < 4; ++m) {
#pragma unroll
                for (int bj = 0; bj < 2; ++bj)
#pragma unroll
                    for (int n = 0; n < 2; ++n) acc[ai][bj][m][n] = acc[ai][bj][m][n] * rs[ai][m];
                asm volatile("" : "+v"(acc[ai][0][m][0]), "+v"(acc[ai][0][m][1]), "+v"(acc[ai][1][m][0]), "+v"(acc[ai][1][m][1])); }
        if (fr >= 14) {
#pragma unroll
            for (int ai = 0; ai < 2; ++ai)
#pragma unroll
                for (int bj = 0; bj < 2; ++bj)
#pragma unroll
                    for (int n = 0; n < 2; ++n) *(PG8_LAS f32x4*)(H + ((2 * ai + wr) * 2 + (fr - 14)) * 256 + bj * HALF + ct0 + 4 * n) = acc[ai][bj][3][n];
        }
        { int fre = fr, cte = ct0; asm volatile("" : "+v"(fre), "+v"(cte));
          float* Ep = E + (size_t)u.pm * 4 * FF2 + (size_t)u.pn * BM + cte;
          if (wr == 0 && fre < 2) {
#pragma unroll
              for (int bj = 0; bj < 2; ++bj)
#pragma unroll
                  for (int n = 0; n < 2; ++n) *(f32x4*)(Ep + (size_t)fre * FF2 + bj * HALF + 4 * n) = acc[0][bj][0][n]; }
          if (wr == 1 && fre >= 14) {
#pragma unroll
              for (int bj = 0; bj < 2; ++bj)
#pragma unroll
                  for (int n = 0; n < 2; ++n) *(f32x4*)(Ep + (size_t)(fre - 12) * FF2 + bj * HALF + 4 * n) = acc[1][bj][3][n]; } }
        asm volatile("s_waitcnt lgkmcnt(0)" ::: "memory"); __builtin_amdgcn_s_barrier(); asm volatile("" ::: "memory");
        const int oc0 = u.pn * HALF + ct0;
#pragma unroll
        for (int bj = 0; bj < 2; ++bj)
#pragma unroll
            for (int n = 0; n < 2; ++n) {
                const int cc = bj * HALF + ct0 + 4 * n;
                const f32x4 w0 = *(const PG8_LAS f32x4*)(CW + cc), w1 = *(const PG8_LAS f32x4*)(CW + 256 + cc), w2 = *(const PG8_LAS f32x4*)(CW + 512 + cc), bb = *(const PG8_LAS f32x4*)(CW + 768 + cc);
                f32x4 c1, c2;
#pragma unroll
                for (int i = 0; i < 4; ++i) { c1[i] = fr == 0 ? w1[i] : 0.f; c2[i] = fr < 2 ? w0[i] : 0.f; }
#pragma unroll
                for (int ai = 0; ai < 2; ++ai) {
#pragma unroll
                    for (int m = 3; m >= 0; --m) {
                        const f32x4 cur = acc[ai][bj][m][n];
                        const f32x4 ui4 = w2 * cur + bb; float u0 = ui4[0], u1 = ui4[1], u2 = ui4[2], u3 = ui4[3];
                        conv_cur2(u0, u1, cur[0], cur[1], w1[0], w1[1], w0[0], w0[1]);
                        conv_cur2(u2, u3, cur[2], cur[3], w1[2], w1[3], w0[2], w0[3]);
                        if (m > 0) {
                            const f32x4 prev = acc[ai][bj][m - 1][n];
                            conv_prev2(u0, u1, prev[0], prev[1], c1[0], c1[1], c2[0], c2[1]);
                            conv_prev2(u2, u3, prev[2], prev[3], c1[2], c1[3], c2[2], c2[3]);
                        }
                        f32x4 uu = (f32x4){u0, u1, u2, u3};
                        if (m == 0) {
                            const int q = 2 * ai + wr;
                            if (q != 0) { const f32x4 h63 = *(const PG8_LAS f32x4*)(H + ((q - 1) * 2 + 1) * 256 + bj * HALF + ct0 + 4 * n), h62 = *(const PG8_LAS f32x4*)(H + ((q - 1) * 2 + 0) * 256 + bj * HALF + ct0 + 4 * n);
#pragma unroll
                                for (int i = 0; i < 4; ++i) uu[i] += c1[i] * h63[i] + c2[i] * (fr == 0 ? h62[i] : h63[i]); }
                        }
                        acc[ai][bj][m][n] = uu;
                        asm volatile("" : "+v"(acc[ai][bj][m][n]));
                        __builtin_amdgcn_sched_barrier(0);
                    }
                }
            }
#pragma unroll
        for (int ai = 0; ai < 2; ++ai)
#pragma unroll
            for (int m = 0; m < 4; ++m) { bf16_t* rowp = ACT + (size_t)(row0 + ai * HALF + m * 16) * FF + oc0;
                f32x4 a0, a1;
#pragma unroll
                for (int i = 0; i < 4; ++i) { a0[i] = silu_f(acc[ai][0][m][0][i]) * acc[ai][1][m][0][i]; a1[i] = silu_f(acc[ai][0][m][1][i]) * acc[ai][1][m][1][i]; }
                u32x4 w; w.x = cvt_pk_bf16(a0[0], a0[1]); w.y = cvt_pk_bf16(a0[2], a0[3]); w.z = cvt_pk_bf16(a1[0], a1[1]); w.w = cvt_pk_bf16(a1[2], a1[3]);
                __builtin_nontemporal_store(w, (u32x4*)rowp); }
    }
};

template <class Epi, class Sched, bool ALIGN_EPI = false, bool SP2 = false>
__device__ __forceinline__ void gemm_phase(PG8_LAS unsigned char* lds, PG8_LAS unsigned char* ldsx, const Gemm g, const Sched& S, const Epi& E) {
    int tid_ = threadIdx.x; asm volatile("" : "+v"(tid_));
    const int tid = tid_, wid = __builtin_amdgcn_readfirstlane(tid >> 6), lane = tid & 63, wr = wid >> 2, wc = wid & 3, fr = lane & 15, fq = lane >> 4;
    const int K = g.K, nt = K / BK;
    unsigned voffA[2], voffB[2];
#pragma unroll
    for (int i = 0; i < 2; ++i) { int R, C; stage_rc(tid * 16 + i * 8192, R, C); const int Rb = Epi::PERM ? ((R & ~31) + perm32(R & 31)) : R;
        voffA[i] = (unsigned)(R * K + C) * 2u; voffB[i] = (unsigned)(Rb * K + C) * 2u; }
    const size_t kstep = (size_t)(BK * 2);
    const size_t hstep = (size_t)HALF * K * 2;
    const size_t tstep = 2 * hstep;
    const unsigned ldsw = (unsigned)wid * 1024u;
    const int aoff = lds_byte(wr * 64 + fr, fq * 8), boff = lds_byte(wc * 32 + fr, fq * 8);
#define PG8_SA(b, h) (((b) * 2 + (h)) * HTB)
#define PG8_SB(b, h) ((4 + (b) * 2 + (h)) * HTB)
#define PG8_STAGE(bufoff, gbase, voff) do { _Pragma("unroll") for (int _i = 0; _i < 2; ++_i) \
        __builtin_amdgcn_global_load_lds((const unsigned*)((const char*)(gbase) + (voff)[_i]), (PG8_LAS unsigned*)(lds + (bufoff) + ldsw + _i * 8192), 16, 0, 0); } while (0)
#define PG8_LDA(dst, b, h) do { _Pragma("unroll") for (int m = 0; m < 4; ++m) _Pragma("unroll") for (int k = 0; k < 2; ++k) dst[m][k] = *(const PG8_LAS bf16x8*)(lds + PG8_SA(b, h) + aoff + m * 2048 + k * 1024); } while (0)
#define PG8_LDB(dst, b, h) do { _Pragma("unroll") for (int n = 0; n < 2; ++n) _Pragma("unroll") for (int k = 0; k < 2; ++k) dst[n][k] = *(const PG8_LAS bf16x8*)(lds + PG8_SB(b, h) + boff + n * 2048 + k * 1024); } while (0)
#define PG8_MMA(ai, bj, At, Bt) do { __builtin_amdgcn_s_setprio(1); _Pragma("unroll") for (int m = 0; m < 4; ++m) _Pragma("unroll") for (int n = 0; n < 2; ++n) _Pragma("unroll") for (int k = 0; k < 2; ++k) \
        acc[ai][bj][m][n] = __builtin_amdgcn_mfma_f32_16x16x32_bf16(Bt[n][k], At[m][k], acc[ai][bj][m][n], 0, 0, 0); __builtin_amdgcn_s_setprio(0); } while (0)
#define PG8_WAIT_V(n) asm volatile("s_waitcnt vmcnt(" #n ")" ::: "memory")
#define PG8_WAIT_L(n) asm volatile("s_waitcnt lgkmcnt(" #n ")" ::: "memory")
#define PG8_BAR __builtin_amdgcn_s_barrier()
#define PG8_SCHED __builtin_amdgcn_sched_barrier(0)
    Unit cur, nxt; int ui = 0;
    if (!S.next(0, cur)) return;
    f32x4 acc[2][2][4][2];
#pragma unroll
    for (int a = 0; a < 2; ++a)
#pragma unroll
        for (int b = 0; b < 2; ++b)
#pragma unroll
            for (int m = 0; m < 4; ++m)
#pragma unroll
                for (int n = 0; n < 2; ++n) acc[a][b][m][n] = (f32x4){0.f, 0.f, 0.f, 0.f};
    bf16x8 At[4][2], B0[2][2], B1[2][2];
    const char* cA = (const char*)g.A + (size_t)cur.pm * tstep; const char* cB = (const char*)g.Bt + (size_t)cur.pn * tstep;
    S.a_ready(cur);
    if constexpr (SP2) {
        PG8_STAGE(PG8_SB(0, 0), cB, voffB); PG8_STAGE(PG8_SB(0, 1), cB + hstep, voffB); PG8_STAGE(PG8_SA(0, 0), cA, voffA); PG8_STAGE(PG8_SA(0, 1), cA + hstep, voffA);
        if (wr == 1) PG8_BAR;
        PG8_WAIT_V(2); PG8_BAR;
        PG8_STAGE(PG8_SB(1, 0), cB + kstep, voffB); PG8_STAGE(PG8_SA(1, 0), cA + kstep, voffA); PG8_STAGE(PG8_SB(1, 1), cB + hstep + kstep, voffB);
        PG8_WAIT_V(6); PG8_BAR;
    } else {
        PG8_STAGE(PG8_SB(0, 0), cB, voffB); PG8_STAGE(PG8_SA(0, 0), cA, voffA); PG8_STAGE(PG8_SB(0, 1), cB + hstep, voffB); PG8_STAGE(PG8_SA(0, 1), cA + hstep, voffA);
        if (wr == 1) PG8_BAR;
        PG8_WAIT_V(4); PG8_BAR;
        PG8_STAGE(PG8_SB(1, 0), cB + kstep, voffB); PG8_STAGE(PG8_SA(1, 0), cA + kstep, voffA); PG8_STAGE(PG8_SB(1, 1), cB + hstep + kstep, voffB);
        PG8_WAIT_V(6); PG8_BAR;
    }
    for (;;) {
        const bool has_next = S.next(ui + 1, nxt);
        const char* nA = has_next ? (const char*)g.A + (size_t)nxt.pm * tstep : cA; const char* nB = has_next ? (const char*)g.Bt + (size_t)nxt.pn * tstep : cB;
        for (int t = 0; t < nt; t += 2) {
            const bool last = (t == nt - 2);
            const char* a1 = cA + (size_t)(t + 1) * kstep;
            const char* a2 = last ? nA : cA + (size_t)(t + 2) * kstep; const char* b2 = last ? nB : cB + (size_t)(t + 2) * kstep;
            const char* a3 = a2 + kstep; const char* b3 = b2 + kstep;
            if (last && has_next) S.a_ready(nxt);
            if constexpr (SP2) {
            PG8_LDB(B0, 0, 0); PG8_LDB(B1, 0, 1); PG8_SCHED; PG8_LDA(At, 0, 0); PG8_STAGE(PG8_SA(1, 1), a1 + hstep, voffA);
            PG8_WAIT_V(8); PG8_WAIT_L(0); PG8_BAR; PG8_MMA(0, 0, At, B0); PG8_MMA(0, 1, At, B1); PG8_BAR; PG8_SCHED;
            PG8_LDA(At, 0, 1); PG8_STAGE(PG8_SB(0, 0), b2, voffB); PG8_STAGE(PG8_SB(0, 1), b2 + hstep, voffB); PG8_STAGE(PG8_SA(0, 0), a2, voffA);
            PG8_WAIT_V(8); PG8_WAIT_L(0); PG8_BAR; PG8_MMA(1, 0, At, B0); PG8_MMA(1, 1, At, B1); PG8_BAR; PG8_SCHED;
            PG8_LDB(B0, 1, 0); PG8_LDB(B1, 1, 1); PG8_SCHED; PG8_LDA(At, 1, 0); PG8_STAGE(PG8_SA(0, 1), a2 + hstep, voffA);
            PG8_WAIT_V(8); PG8_WAIT_L(0); PG8_BAR; PG8_MMA(0, 0, At, B0); PG8_MMA(0, 1, At, B1); PG8_BAR; PG8_SCHED;
            PG8_LDA(At, 1, 1); PG8_STAGE(PG8_SB(1, 0), b3, voffB); PG8_STAGE(PG8_SB(1, 1), b3 + hstep, voffB); PG8_STAGE(PG8_SA(1, 0), a3, voffA);
            PG8_WAIT_V(8); PG8_WAIT_L(0); PG8_BAR; PG8_MMA(1, 0, At, B0); PG8_MMA(1, 1, At, B1); PG8_BAR; PG8_SCHED;
            } else {
            PG8_LDB(B0, 0, 0); PG8_SCHED; PG8_LDA(At, 0, 0); PG8_STAGE(PG8_SA(1, 1), a1 + hstep, voffA);
            PG8_WAIT_L(8); PG8_BAR; PG8_WAIT_L(0); PG8_MMA(0, 0, At, B0); PG8_BAR; PG8_SCHED;
            PG8_LDB(B1, 0, 1); PG8_STAGE(PG8_SB(0, 0), b2, voffB);
            PG8_BAR; PG8_WAIT_L(0); PG8_MMA(0, 1, At, B1); PG8_BAR;
            PG8_LDA(At, 0, 1); PG8_STAGE(PG8_SA(0, 0), a2, voffA);
            PG8_BAR; PG8_WAIT_L(0); PG8_MMA(1, 0, At, B0); PG8_BAR; PG8_SCHED;
            PG8_STAGE(PG8_SB(0, 1), b2 + hstep, voffB);
            PG8_WAIT_V(6); PG8_BAR; PG8_MMA(1, 1, At, B1); PG8_BAR;
            PG8_LDB(B0, 1, 0); PG8_SCHED; PG8_LDA(At, 1, 0); PG8_STAGE(PG8_SA(0, 1), a2 + hstep, voffA);
            PG8_WAIT_L(8); PG8_BAR; PG8_WAIT_L(0); PG8_MMA(0, 0, At, B0); PG8_BAR; PG8_SCHED;
            PG8_LDB(B1, 1, 1); PG8_STAGE(PG8_SB(1, 0), b3, voffB);
            PG8_BAR; PG8_WAIT_L(0); PG8_MMA(0, 1, At, B1); PG8_BAR;
            PG8_LDA(At, 1, 1); PG8_STAGE(PG8_SA(1, 0), a3, voffA);
            PG8_BAR; PG8_WAIT_L(0); PG8_MMA(1, 0, At, B0); PG8_BAR; PG8_SCHED;
            PG8_STAGE(PG8_SB(1, 1), b3 + hstep, voffB);
            PG8_WAIT_V(6); PG8_BAR; PG8_MMA(1, 1, At, B1); PG8_BAR;
            }
        }
        if constexpr (ALIGN_EPI) { if (wr == 0) PG8_BAR; }
        if constexpr (!Epi::AFTER_DRAIN) { E(acc, cur, wr, wc, fr, fq, ldsx, ui, wid, lane); S.done(cur); }
        if (!has_next) break;
#pragma unroll
        for (int a = 0; a < 2; ++a)
#pragma unroll
            for (int b = 0; b < 2; ++b)
#pragma unroll
                for (int m = 0; m < 4; ++m)
#pragma unroll
                    for (int n = 0; n < 2; ++n) acc[a][b][m][n] = (f32x4){0.f, 0.f, 0.f, 0.f};
        cur = nxt; cA = nA; cB = nB; ++ui;
        if constexpr (ALIGN_EPI) { if (wr == 1) PG8_BAR; }
    }
    PG8_WAIT_V(0);
    if constexpr (!ALIGN_EPI) { if (wr == 0) PG8_BAR; }
    PG8_BAR;
    if constexpr (Epi::AFTER_DRAIN) { E.fused(acc, cur, wr, wc, fr, fq, lds, wid, lane); S.done(cur); }
#undef PG8_SA
#undef PG8_SB
#undef PG8_STAGE
#undef PG8_LDA
#undef PG8_LDB
#undef PG8_MMA
#undef PG8_WAIT_V
#undef PG8_WAIT_L
#undef PG8_BAR
#undef PG8_SCHED
}
}
namespace att {
typedef __attribute__((address_space(3))) unsigned char lds_u8;
typedef unsigned short bf16_t;
typedef short bf16x8 __attribute__((ext_vector_type(8)));
typedef short v4i16 __attribute__((ext_vector_type(4)));
typedef float f32x16 __attribute__((ext_vector_type(16)));
typedef float f32x4 __attribute__((ext_vector_type(4)));
typedef unsigned u32x4 __attribute__((ext_vector_type(4)));
typedef unsigned u32x2 __attribute__((ext_vector_type(2)));
typedef float f32x2 __attribute__((ext_vector_type(2)));
#define ATT_LAS __attribute__((address_space(3)))
constexpr int KROWB = 144, NKEY = 384, LDS_K = 0, LDS_V = NKEY * KROWB  , VBLK = NKEY * 64  , LDS_BT = LDS_V + 2 * VBLK  , LDS_NT = LDS_BT + 5 * 4096  , LDS_TB = LDS_NT + 4096  , LDS_END = LDS_TB + 1024;
constexpr float NEG_BIG = -1.0e30f;
typedef __bf16 bf16x2_c __attribute__((ext_vector_type(2)));
__device__ __forceinline__ unsigned cvtpk(float lo, float hi) { const f32x2 v = {lo, hi}; const bf16x2_c b = __builtin_convertvector(v, bf16x2_c); return __builtin_bit_cast(unsigned, b); }
__device__ __forceinline__ float bf_lo(unsigned w) { return __builtin_bit_cast(float, w << 16); }
__device__ __forceinline__ float bf_hi(unsigned w) { return __builtin_bit_cast(float, w & 0xffff0000u); }
__device__ __forceinline__ int t5_bucket(int n) {
    if (n < 16) return n;
    int large = 16 + (int)(logf((float)n / 16.0f) / 4.852030263919617f * 16.0f);
    return large < 31 ? large : 31;
}
struct Unit { int b, h, dil, res, l0; };
struct Bufs { const bf16_t* Q; const bf16_t* K; const bf16_t* V; const float* rel_bias; bf16_t* Oa; bf16_t* Ob; float* STa; float* STb; bf16_t* Oout; };
struct Pre { u32x4 k[6], v[6]; };

template <bool FINAL> __device__ __forceinline__ Unit decode(int i, int G) {
    Unit u; int bh, sub;
    if (G == 256) { const int x = blockIdx.x & 7, c32 = blockIdx.x >> 3, c16 = c32 & 15; const int h = 2 * x + (c32 >> 4);
        if (FINAL) { bh = i * 16 + h; sub = c16; } else { bh = (i >> 1) * 16 + h; sub = 2 * c16 + (i & 1); } }
    else { const int uu = blockIdx.x + i * G; bh = uu & 255; sub = uu >> 8; }
    u.b = bh >> 4; u.h = bh & 15;
    if (FINAL) { u.dil = 16; u.res = sub; u.l0 = 0; }
    else if (sub < 16) { u.dil = 1; u.res = 0; u.l0 = 256 * sub; }
    else { u.dil = 4; u.res = sub & 3; u.l0 = 256 * ((sub & 15) >> 2); }
    return u;
}
template <bool FINAL> __device__ __forceinline__ int unit_count(int G) { const int total = FINAL ? 256 * 16 : 256 * 32; if (G == 256) return total / 256; return (total - (int)blockIdx.x + G - 1) / G; }
__device__ __forceinline__ void prefetch(Pre& P, const Unit& u, const Bufs& B, int tid, int wid, int q, int hi) {
    const size_t ubase = ((size_t)(u.b * NH + u.h) * SEQ + u.res) * HD; const bf16_t* Kp = B.K + ubase; const bf16_t* Vp = B.V + ubase;
    const int lsh = 6 + (u.dil == 1 ? 0 : (u.dil == 4 ? 2 : 4)), lb = u.l0 - 128;
#pragma unroll
    for (int j = 0; j < 6; ++j) { const int c = tid + 512 * j; int l = lb + (c >> 3); l = l < 0 ? 0 : l; const unsigned off = ((unsigned)l << lsh) + (unsigned)(c & 7) * 8u;
        P.k[j] = *(const u32x4*)(Kp + off); P.v[j] = *(const u32x4*)(Vp + off); }
}

template <bool FINAL>
__device__ __forceinline__ void attn_phase(lds_u8* lds, const Bufs& B) {
    int tid_ = threadIdx.x; asm volatile("" : "+v"(tid_));
    const int tid = tid_, lane = tid & 63, q = lane & 31, hi = lane >> 5; const int wid = __builtin_amdgcn_readfirstlane(tid >> 6);
    const int G = gridDim.x;
    const int nmine = unit_count<FINAL>(G); int ui = 0; if (nmine <= 0) return;
    ATT_LAS float* tb = (ATT_LAS float*)(lds + LDS_TB); ATT_LAS float* BT = (ATT_LAS float*)(lds + LDS_BT);
    Unit u = decode<FINAL>(0, G); Pre P; prefetch(P, u, B, tid, wid, q, hi);
    bf16x8 qn[4];
    if (!FINAL) { const size_t qt0 = (size_t)(u.b * NH + u.h) * SEQ + (size_t)(u.l0 + 32 * wid + q) * u.dil + u.res;
#pragma unroll
      for (int ks = 0; ks < 4; ++ks) qn[ks] = *(const bf16x8*)(B.Q + qt0 * HD + ks * 16 + hi * 8); }
    int tkey = -1;
    const int kbase = LDS_K + (32 * wid + q) * KROWB + hi * 16;
    const int g = lane >> 4, i16 = lane & 15;
    const int vbase = LDS_V + (32 * wid + 4 * (g >> 1) + (i16 >> 2)) * 64 + (16 * (g & 1) + 4 * (i16 & 3)) * 2;
    for (;;) {
        if (u.h * 32 + u.dil != tkey) { tkey = u.h * 32 + u.dil;
            if (tid < 129) tb[tid] = B.rel_bias[t5_bucket(tid * u.dil) * NH + u.h] * LOG2E;
            __syncthreads();
#pragma unroll
            for (int i = 0; i < 10; ++i) { const int idx = tid + 512 * i, j = idx & 3, ln = (idx >> 2) & 63, gq = (idx >> 8) & 3, kb = idx >> 10;
                const int delta = 128 - 32 * kb + (ln & 31) - (j + 8 * gq + 4 * (ln >> 5));
                BT[idx] = (delta >= 0 && delta <= 128) ? tb[delta < 0 ? 0 : (delta > 128 ? 128 : delta)] : NEG_BIG; }
#pragma unroll
            for (int i = 0; i < 2; ++i) BT[5 * 1024 + tid + 512 * i] = NEG_BIG; }
        const Unit cu = u; const int qpos = (cu.l0 + 32 * wid + q) * cu.dil + cu.res;
        const size_t qhm = (size_t)(cu.b * NH + cu.h) * SEQ + qpos;
        const size_t qtok = (size_t)cu.b * SEQ + qpos; const int hoff = cu.h * HD;
        bf16x8 qf[4];
#pragma unroll
        for (int ks = 0; ks < 4; ++ks) qf[ks] = FINAL ? *(const bf16x8*)(B.Q + qhm * HD + ks * 16 + hi * 8) : qn[ks];
#pragma unroll
        for (int j = 0; j < 6; ++j) { const int c = tid + 512 * j, row = c >> 3, ch = c & 7;
            *(ATT_LAS u32x4*)(lds + LDS_K + row * KROWB + ch * 16) = P.k[j];
            *(ATT_LAS u32x4*)(lds + LDS_V + (ch >> 2) * VBLK + row * 64 + (ch & 3) * 16) = P.v[j]; }
        __syncthreads();
        const bool has_next = ui + 1 < nmine;
        if (has_next) { u = decode<FINAL>(ui + 1, G); prefetch(P, u, B, tid, wid, q, hi); }
        const int kb0 = (cu.l0 == 0) ? (4 - wid > 0 ? 4 - wid : 0) : 0;
        f32x16 s[5];
#pragma unroll
        for (int kb = 0; kb < 5; ++kb) {
            if (!FINAL) {
                const int tsel = __builtin_amdgcn_readfirstlane(kb >= kb0 ? kb : 5);
#pragma unroll
                for (int gq = 0; gq < 4; ++gq) { const f32x4 t = *(const ATT_LAS f32x4*)(BT + ((tsel * 4 + gq) * 64 + lane) * 4);
                    s[kb][4 * gq] = t[0]; s[kb][4 * gq + 1] = t[1]; s[kb][4 * gq + 2] = t[2]; s[kb][4 * gq + 3] = t[3]; }
#pragma unroll
                for (int ks = 0; ks < 4; ++ks) { const bf16x8 kf = *(const ATT_LAS bf16x8*)(lds + kbase + kb * 32 * KROWB + ks * 32);
                    s[kb] = __builtin_amdgcn_mfma_f32_32x32x16_bf16(kf, qf[ks], s[kb], 0, 0, 0); }
            } else if (kb >= kb0) {
#pragma unroll
                for (int gq = 0; gq < 4; ++gq) { const f32x4 t = *(const ATT_LAS f32x4*)(BT + ((kb * 4 + gq) * 64 + lane) * 4); s[kb][4 * gq] = t[0]; s[kb][4 * gq + 1] = t[1]; s[kb][4 * gq + 2] = t[2]; s[kb][4 * gq + 3] = t[3]; }
#pragma unroll
                for (int ks = 0; ks < 4; ++ks) { const bf16x8 kf = *(const ATT_LAS bf16x8*)(lds + kbase + kb * 32 * KROWB + ks * 32);
                    s[kb] = __builtin_amdgcn_mfma_f32_32x32x16_bf16(kf, qf[ks], s[kb], 0, 0, 0); }
            } else {
#pragma unroll
                for (int r = 0; r < 16; ++r) s[kb][r] = NEG_BIG;
            }
        }
        float mx = NEG_BIG;
#pragma unroll
        for (int kb = 0; kb < 5; ++kb)
#pragma unroll
            for (int r = 0; r < 16; ++r) mx = fmaxf(mx, s[kb][r]);
        mx = fmaxf(mx, __shfl_xor(mx, 32));
        float lsum = 0.f; f32x16 o0 = {}, o1 = {};
        f32x2 st1 = {0.f, 0.f}, st2 = {0.f, 0.f}; u32x2 xa[4][2], xb[4][2];
#pragma unroll
        for (int kb = 0; kb < 5; ++kb) {
            if (!FINAL || kb >= kb0) {
#pragma unroll
                for (int r = 0; r < 16; ++r) { s[kb][r] = __builtin_amdgcn_exp2f(s[kb][r] - mx); lsum += s[kb][r]; }
                u32x4 pw0, pw1;
                pw0.x = cvtpk(s[kb][0], s[kb][1]); pw0.y = cvtpk(s[kb][2], s[kb][3]); pw0.z = cvtpk(s[kb][4], s[kb][5]); pw0.w = cvtpk(s[kb][6], s[kb][7]);
                pw1.x = cvtpk(s[kb][8], s[kb][9]); pw1.y = cvtpk(s[kb][10], s[kb][11]); pw1.z = cvtpk(s[kb][12], s[kb][13]); pw1.w = cvtpk(s[kb][14], s[kb][15]);
                const bf16x8 p0 = __builtin_bit_cast(bf16x8, pw0), p1 = __builtin_bit_cast(bf16x8, pw1);
#pragma unroll
                for (int db = 0; db < 2; ++db) {
                    const int a = vbase + db * VBLK + kb * 32 * 64;
                    const v4i16 a0 = __builtin_amdgcn_ds_read_tr16_b64_v4i16((ATT_LAS v4i16*)(lds + a));
                    const v4i16 a1 = __builtin_amdgcn_ds_read_tr16_b64_v4i16((ATT_LAS v4i16*)(lds + a + 8 * 64));
                    const v4i16 a2 = __builtin_amdgcn_ds_read_tr16_b64_v4i16((ATT_LAS v4i16*)(lds + a + 16 * 64));
                    const v4i16 a3 = __builtin_amdgcn_ds_read_tr16_b64_v4i16((ATT_LAS v4i16*)(lds + a + 24 * 64));
                    const bf16x8 v0 = (bf16x8){a0[0], a0[1], a0[2], a0[3], a1[0], a1[1], a1[2], a1[3]};
                    const bf16x8 v1 = (bf16x8){a2[0], a2[1], a2[2], a2[3], a3[0], a3[1], a3[2], a3[3]};
                    if (db == 0) { o0 = __builtin_amdgcn_mfma_f32_32x32x16_bf16(v0, p0, o0, 0, 0, 0); o0 = __builtin_amdgcn_mfma_f32_32x32x16_bf16(v1, p1, o0, 0, 0, 0); }
                    else         { o1 = __builtin_amdgcn_mfma_f32_32x32x16_bf16(v0, p0, o1, 0, 0, 0); o1 = __builtin_amdgcn_mfma_f32_32x32x16_bf16(v1, p1, o1, 0, 0, 0); }
                }
            }
            if (kb == 2) __builtin_amdgcn_sched_barrier(0);
            if (FINAL && kb == 2) {
            st1 = *(const f32x2*)(B.STa + qhm * 2); st2 = *(const f32x2*)(B.STb + qhm * 2);
            const size_t ooff = qhm * HD + 4 * hi;
#pragma unroll
            for (int gq = 0; gq < 4; ++gq)
#pragma unroll
                for (int db = 0; db < 2; ++db) { xa[gq][db] = *(const u32x2*)(B.Oa + ooff + 32 * db + 8 * gq); xb[gq][db] = *(const u32x2*)(B.Ob + ooff + 32 * db + 8 * gq); }
            }
            if (!FINAL && kb == 2 && has_next) { const size_t qt1 = (size_t)(u.b * NH + u.h) * SEQ + (size_t)(u.l0 + 32 * wid + q) * u.dil + u.res;
#pragma unroll
                for (int ks = 0; ks < 4; ++ks) qn[ks] = *(const bf16x8*)(B.Q + qt1 * HD + ks * 16 + hi * 8); }
        }
        const float l_tot = lsum + __shfl_xor(lsum, 32);
        u32x2 ow[8];
        bf16_t* orow;
        if (!FINAL) {
            const float inv = 1.0f / l_tot;
#pragma unroll
            for (int gq = 0; gq < 4; ++gq) {
                ow[gq].x = cvtpk(o0[4 * gq] * inv, o0[4 * gq + 1] * inv); ow[gq].y = cvtpk(o0[4 * gq + 2] * inv, o0[4 * gq + 3] * inv);
                ow[4 + gq].x = cvtpk(o1[4 * gq] * inv, o1[4 * gq + 1] * inv); ow[4 + gq].y = cvtpk(o1[4 * gq + 2] * inv, o1[4 * gq + 3] * inv); }
            orow = (cu.dil == 1 ? B.Oa : B.Ob) + qhm * HD;
            if (hi == 0) *(f32x2*)((cu.dil == 1 ? B.STa : B.STb) + qhm * 2) = (f32x2){mx, l_tot};
        } else {
            const f32x2 s1 = st1, s2 = st2;
            const float m_all = fmaxf(fmaxf(s1.x, s2.x), mx);
            const float e1 = s1.y * __builtin_amdgcn_exp2f(s1.x - m_all), e2 = s2.y * __builtin_amdgcn_exp2f(s2.x - m_all), e3 = __builtin_amdgcn_exp2f(mx - m_all);
            const float inv = 1.0f / (e1 + e2 + e3 * l_tot);
            const float c1 = e1 * inv, c2 = e2 * inv, c3 = e3 * inv;
#pragma unroll
            for (int gq = 0; gq < 4; ++gq) {
#pragma unroll
                for (int db = 0; db < 2; ++db) {
                    const u32x2 x1 = xa[gq][db], x2 = xb[gq][db];
                    const float a0 = db == 0 ? o0[4 * gq] : o1[4 * gq], a1 = db == 0 ? o0[4 * gq + 1] : o1[4 * gq + 1], a2 = db == 0 ? o0[4 * gq + 2] : o1[4 * gq + 2], a3 = db == 0 ? o0[4 * gq + 3] : o1[4 * gq + 3];
                    u32x2 w; w.x = cvtpk(c1 * bf_lo(x1.x) + c2 * bf_lo(x2.x) + c3 * a0, c1 * bf_hi(x1.x) + c2 * bf_hi(x2.x) + c3 * a1);
                    w.y = cvtpk(c1 * bf_lo(x1.y) + c2 * bf_lo(x2.y) + c3 * a2, c1 * bf_hi(x1.y) + c2 * bf_hi(x2.y) + c3 * a3);
                    ow[4 * db + gq] = w; } }
            orow = B.Oout + qtok * DM + hoff;
        }
#pragma unroll
        for (int pp = 0; pp < 4; ++pp) { u32x2 a = ow[2 * pp], b = ow[2 * pp + 1];
            { auto r = __builtin_amdgcn_permlane32_swap(a.x, b.x, false, false); a.x = r[0]; b.x = r[1]; }
            { auto r = __builtin_amdgcn_permlane32_swap(a.y, b.y, false, false); a.y = r[0]; b.y = r[1]; }
            *(u32x4*)(orow + 16 * pp + 8 * hi) = (u32x4){a.x, a.y, b.x, b.y}; }
        __syncthreads();
        if (!has_next) break;
        ++ui;
    }
}
}

#define LAS __attribute__((address_space(3)))
typedef unsigned short bf16;
typedef unsigned v4u __attribute__((ext_vector_type(4)));
typedef unsigned v2u __attribute__((ext_vector_type(2)));
typedef float f32x4 __attribute__((ext_vector_type(4)));
constexpr int NWAVES = 8, NTHREADS = 512;
constexpr size_t MiB = 1u << 20;
constexpr size_t WS_SS = 0;
constexpr size_t WS_E = 4 * MiB;
constexpr size_t WS_BAR = 46 * MiB, WS_BAR_BYTES = 16384;
constexpr size_t WS_ST = 28 * MiB;
constexpr size_t WS_WIN = 48 * MiB, WS_WOUT = 54 * MiB, WS_WUP0 = 56 * MiB, WS_WUP1 = 67 * MiB, WS_WD0 = 78 * MiB, WS_WD1 = 84 * MiB, WS_WQKV = 90 * MiB, WS_WO = 96 * MiB;
constexpr size_t WS_XN = 128 * MiB;
constexpr size_t WS_BIG = 256 * MiB;
constexpr size_t WS_O = 640 * MiB;
constexpr size_t WS_O2 = 768 * MiB;
constexpr size_t WS_OF = 896 * MiB;
constexpr size_t WS_END = 1024 * MiB;
constexpr int LDS_RING = 131072, LDS_X = LDS_RING, LDS_MISC = LDS_RING + 24576  , LDS_BYTES = LDS_MISC + 64;

__device__ __forceinline__ unsigned f2bf(float f) { unsigned u = __builtin_bit_cast(unsigned, f); return (u + 0x7fffu + ((u >> 16) & 1u)) >> 16; }
__device__ __forceinline__ unsigned pk2(float lo, float hi) { return f2bf(lo) | (f2bf(hi) << 16); }
__device__ __forceinline__ float bflo(unsigned w) { return __builtin_bit_cast(float, w << 16); }
__device__ __forceinline__ float bfhi(unsigned w) { return __builtin_bit_cast(float, w & 0xffff0000u); }
__device__ __forceinline__ float wave_sum(float v) {
#pragma unroll
    for (int o = 1; o < 64; o <<= 1) v += __shfl_xor(v, o);
    return v;
}
__device__ __forceinline__ void transpose_item(const float* W, int K, int N, const float* gain, bf16* WT, int k0, int n0, int drow0, LAS float* scr, int lane) {
    float wv[32];
#pragma unroll
    for (int i = 0; i < 32; ++i) wv[i] = W[(size_t)(k0 + 2 * i + (lane >> 5)) * N + n0 + (lane & 31)];
#pragma unroll
    for (int i = 0; i < 32; ++i) { const int kk = 2 * i + (lane >> 5); const float gk = gain ? gain[k0 + kk] : 1.0f; scr[kk * 33 + (lane & 31)] = wv[i] * gk; }
    asm volatile("s_waitcnt lgkmcnt(0)" ::: "memory");
    const int c = lane & 7;
#pragma unroll
    for (int j = 0; j < 4; ++j) { const int n = (lane >> 3) + 8 * j; const LAS float* s = scr + (8 * c) * 33 + n;
        v4u o; o.x = pk2(s[0 * 33], s[1 * 33]); o.y = pk2(s[2 * 33], s[3 * 33]); o.z = pk2(s[4 * 33], s[5 * 33]); o.w = pk2(s[6 * 33], s[7 * 33]);
        *(v4u*)(WT + (size_t)(drow0 + n) * K + k0 + 8 * c) = o; }
    asm volatile("s_waitcnt lgkmcnt(0)" ::: "memory");
}
template <int MODE> __device__ __forceinline__ int dest_row(int n0) {
    if (MODE == 0) return n0;
    if (MODE == 1) { if (n0 < DM) return n0; const int part = (n0 - DM) / DM  , j = (n0 - DM) % DM; return DM + (j / 128) * 256 + part * 128 + (j % 128); }
    { const int part = n0 / FF, j = n0 % FF; return (j / 128) * 256 + part * 128 + (j % 128); }
}
template <int MODE> __device__ __forceinline__ void convert_matrix(const float* W, int K, int N, const float* gain, bf16* WT, int row_off, LAS float* scr, int gw, int ngw, int lane) {
    const int nblk = N / 32, items = (K / 64) * nblk;
    for (int it = gw; it < items; it += ngw) { const int kb = it / nblk, nb = it % nblk; transpose_item(W, K, N, gain, WT, 64 * kb, 32 * nb, row_off + dest_row<MODE>(32 * nb), scr, lane); }
}

typedef unsigned v4u_unused_;
#define XB_TMO      128
#define XB_XCNT(j)  (256  + 64 * (j))
#define XB_XSUB(j)  (1280 + 64 * (j))
#define XB_XGEN(j)  (2304 + 64 * (j))
#define XB_TOP      3328
#define XB_TOPGEN   3392
#define XCD_BAR_WORDS 3456
#define XB_SPIN_CAP (1u << 18)

__device__ __forceinline__ unsigned xb_ld(unsigned* p)              { return __hip_atomic_load(p, __ATOMIC_RELAXED, __HIP_MEMORY_SCOPE_AGENT); }
__device__ __forceinline__ unsigned xb_add(unsigned* p, unsigned v) { return __hip_atomic_fetch_add(p, v, __ATOMIC_RELAXED, __HIP_MEMORY_SCOPE_AGENT); }
__device__ __forceinline__ unsigned xb_xcc_id() { return (unsigned)__builtin_amdgcn_s_getreg((3 << 11) | 20) & 0xFu; }
#define XB_SPIN(cond, bar) do { unsigned _sp = 0; while (cond) { __builtin_amdgcn_s_sleep(1); \
    if ((++_sp & 255u) == 0u) { if (xb_ld(&(bar)[XB_TMO])) break; if (_sp > XB_SPIN_CAP) { atomicAdd(&(bar)[XB_TMO], 1u); break; } } } } while (0)

struct XcdBarrier {
    unsigned* bar; unsigned x;
    volatile LAS unsigned* st;
};

__device__ __forceinline__ XcdBarrier xcd_barrier_post(unsigned* bar, volatile LAS unsigned* st) {
    XcdBarrier b; b.bar = bar; b.x = xb_xcc_id(); b.st = st;
    if (threadIdx.x == 0) (void)xb_add(&bar[XB_XCNT(b.x)], 1u);
    return b;
}
__device__ __forceinline__ void xcd_barrier_complete(unsigned* bar, unsigned x, unsigned& nloc, unsigned& nx) {
    const unsigned G = gridDim.x * gridDim.y * gridDim.z;
    unsigned sum, cnt, mine, sp = 0u;
    for (;;) {
        sum = 0u; cnt = 0u; mine = 0u;
#pragma unroll
        for (unsigned j = 0; j < 16; ++j) { const unsigned c = xb_ld(&bar[XB_XCNT(j)]); sum += c; cnt += (c > 0u) ? 1u : 0u; mine = (j == x) ? c : mine; }
        if (sum == G) break;
        __builtin_amdgcn_s_sleep(1);
        if ((++sp & 255u) == 0u) { if (xb_ld(&bar[XB_TMO])) break; if (sp > XB_SPIN_CAP) { atomicAdd(&bar[XB_TMO], 1u); break; } }
    }
    nloc = mine > 0u ? mine : 1u; nx = cnt > 0u ? cnt : 1u;
}

__device__ __forceinline__ void xcd_barrier(const XcdBarrier& b) {
    asm volatile("s_waitcnt vmcnt(0)" ::: "memory");
    __syncthreads();
    if (threadIdx.x == 0) {
        unsigned* bar = b.bar;
        __builtin_amdgcn_s_waitcnt(0);
        unsigned nloc = b.st[0], nx = b.st[1];
        if (nloc == 0u) { xcd_barrier_complete(bar, b.x, nloc, nx); b.st[0] = nloc; b.st[1] = nx; }
        const unsigned old = xb_add(&bar[XB_XSUB(b.x)], 1u);
        const unsigned gen = old / nloc;
        if (old + 1u == (gen + 1u) * nloc) {
            __builtin_amdgcn_fence(__ATOMIC_RELEASE, "agent");
            asm volatile("s_waitcnt vmcnt(0)" ::: "memory");
            const unsigned og = xb_add(&bar[XB_TOP], 1u);
            const unsigned tg = og / nx;
            if (og + 1u == (tg + 1u) * nx) xb_add(&bar[XB_TOPGEN], 1u);
            else XB_SPIN(xb_ld(&bar[XB_TOPGEN]) == tg, bar);
            __builtin_amdgcn_fence(__ATOMIC_ACQUIRE, "agent");
            xb_add(&bar[XB_XGEN(b.x)], 1u);
            asm volatile("s_waitcnt vmcnt(0)" ::: "memory");
        } else {
            XB_SPIN(xb_ld(&bar[XB_XGEN(b.x)]) == gen, bar);
            __builtin_amdgcn_fence(__ATOMIC_ACQUIRE, "agent");
            asm volatile("s_waitcnt vmcnt(0)" ::: "memory");
        }
    }
    __syncthreads();
}

struct Args {
    const float* x; const float* a_norm; const float* a_w_in; const float* a_conv; const float* a_w_out; const float* kv_norm; const float* w_kv; const float* b_norm; const float* b_w_q; const float* b_w_o;
    const float* rel_bias; const float* ffn_norm; const float* ffn_w_up; const float* ffn_conv; const float* ffn_conv_b; const float* ffn_w_down; const float* final_norm;
    float* out; unsigned char* ws;
};

template <class Epi> __device__ __forceinline__ void run_gemm(LAS unsigned char* lds, const bf16* A, const bf16* Bt, int N, int K, const Epi& E) {
    pg8::Gemm g{A, Bt, MT, N, K}; pg8::StaticOrder S; S.init(MT, N, (int)gridDim.x, (int)blockIdx.x);
    pg8::gemm_phase<Epi, pg8::StaticOrder, true, true>(lds, lds + LDS_X, g, S, E);
}

__device__ __forceinline__ void ffn_fixup(const float* E, const float* cw, const float* cb, bf16* ACT, int gtid, int gthreads) {
    const int per = FF / 4, total = 256 * per;
    for (int it = gtid; it < total; it += gthreads) { const int pm = it / per, a = (it % per) * 4;
        if ((pm & 15) == 0) continue;
        const int pn = a >> 7, j7 = a & 127, eg = 256 * pn + j7;
        const float* Ec = E + (size_t)pm * 4 * FF2; const float* Ep = E + (size_t)(pm - 1) * 4 * FF2;
        f32x4 uu[2][2];
#pragma unroll
        for (int part = 0; part < 2; ++part) { const int e = eg + part * 128, oc = part * FF + a;
            const f32x4 w0 = *(const f32x4*)(cw + oc), w1 = *(const f32x4*)(cw + FF2 + oc), w2 = *(const f32x4*)(cw + 2 * FF2 + oc), bb = *(const f32x4*)(cb + oc);
            const f32x4 r0 = *(const f32x4*)(Ec + e), r1 = *(const f32x4*)(Ec + FF2 + e), pm2 = *(const f32x4*)(Ep + 2 * FF2 + e), pm1 = *(const f32x4*)(Ep + 3 * FF2 + e);
            uu[part][0] = w2 * r0 + w1 * pm1 + w0 * pm2 + bb; uu[part][1] = w2 * r1 + w1 * r0 + w0 * pm1 + bb; }
#pragma unroll
        for (int j = 0; j < 2; ++j) { f32x4 o;
#pragma unroll
            for (int i = 0; i < 4; ++i) o[i] = pg8::silu_f(uu[0][j][i]) * uu[1][j][i];
            v2u w; w.x = pk2(o[0], o[1]); w.y = pk2(o[2], o[3]); *(v2u*)(ACT + (size_t)(pm * 256 + j) * FF + a) = w; }
    }
}

#ifndef DUP_MASK
#define DUP_MASK 0
#endif
#define PH(k) for (int rep_ = 0; rep_ < 1 + ((DUP_MASK >> (k)) & 1); ++rep_)
#define a (*ap_)
__global__ void __launch_bounds__(NTHREADS, 2) yoco_fwd(Args a_unused) {
    extern __shared__ __attribute__((aligned(16))) unsigned char lds_raw[];
    LAS unsigned char* lds = (LAS unsigned char*)lds_raw;
    cg::grid_group grid = cg::this_grid();
    volatile LAS unsigned* MISC = (volatile LAS unsigned*)(lds + LDS_MISC);
    if (threadIdx.x < 2) MISC[threadIdx.x] = 0u;
    __syncthreads();
    typedef const __attribute__((address_space(4))) Args* ArgsP;
    const ArgsP ap0 = (ArgsP)__builtin_amdgcn_kernarg_segment_ptr();
    (void)xcd_barrier_post((unsigned*)(ap0->ws + WS_BAR), MISC);
#define GRID_BAR() do { XcdBarrier b_; b_.bar = (unsigned*)(ap0->ws + WS_BAR); b_.x = xb_xcc_id(); b_.st = MISC; xcd_barrier(b_); } while (0)
#define PHASE_ARGS() ArgsP ap_ = ap0; asm volatile("" : "+s"(ap_)); unsigned char* ws = ap_->ws; \
    int tid_ = threadIdx.x; asm volatile("" : "+v"(tid_)); const int tid = tid_, lane = tid & 63, wave = __builtin_amdgcn_readfirstlane(tid >> 6); \
    const int G = gridDim.x, gw = blockIdx.x * NWAVES + wave, ngw = G * NWAVES, gtid = blockIdx.x * NTHREADS + tid, gthreads = G * NTHREADS; (void)lane; (void)gw; (void)ngw; (void)gtid; (void)gthreads; \
    float* SS1 = (float*)(ws + WS_SS); float* SS2 = SS1 + 4 * MT; float* SS3 = SS2 + 4 * MT; float* SS4 = SS3 + 4 * MT; \
    float* EB = (float*)(ws + WS_E); float* ST1 = (float*)(ws + WS_ST); float* ST2 = ST1 + (size_t)MT * NH * 2; \
    bf16 *Win_t = (bf16*)(ws + WS_WIN), *Wout_t = (bf16*)(ws + WS_WOUT), *Wup0_t = (bf16*)(ws + WS_WUP0), *Wup1_t = (bf16*)(ws + WS_WUP1), *Wd0_t = (bf16*)(ws + WS_WD0), *Wd1_t = (bf16*)(ws + WS_WD1), \
         *Wqkv_t = (bf16*)(ws + WS_WQKV), *Wo_t = (bf16*)(ws + WS_WO); \
    bf16* XN = (bf16*)(ws + WS_XN); bf16* Bg = (bf16*)(ws + WS_BIG); bf16* CH = Bg + (size_t)MT * DM; bf16* Y = CH + (size_t)MT * DM; bf16* ACT = Bg; \
    bf16 *Qb = Bg, *Kb = CH, *Vb = Y; bf16* Ob = (bf16*)(ws + WS_O); bf16* O1 = Ob; bf16* O2 = (bf16*)(ws + WS_O2); bf16* OF = (bf16*)(ws + WS_OF); (void)OF; \
    (void)SS1; (void)SS2; (void)SS3; (void)SS4; (void)EB; (void)ST1; (void)ST2; (void)Win_t; (void)Wout_t; (void)Wup0_t; (void)Wup1_t; (void)Wd0_t; (void)Wd1_t; (void)Wqkv_t; (void)Wo_t; \
    (void)XN; (void)Bg; (void)CH; (void)Y; (void)ACT; (void)Qb; (void)Kb; (void)Vb; (void)Ob; (void)O1; (void)O2;

    PH(0) { PHASE_ARGS()
        LAS float* scr = (LAS float*)(lds + wave * 16384);
        convert_matrix<1>(a.a_w_in, DM, 3 * DM, nullptr, Win_t, 0, scr, gw, ngw, lane);
        convert_matrix<0>(a.a_w_out, DM, DM, nullptr, Wout_t, 0, scr, gw, ngw, lane);
        convert_matrix<2>(a.ffn_w_up, DM, FF2, a.ffn_norm, Wup0_t, 0, scr, gw, ngw, lane);
        convert_matrix<2>(a.ffn_w_up + (size_t)DM * FF2, DM, FF2, a.ffn_norm + DM, Wup1_t, 0, scr, gw, ngw, lane);
        convert_matrix<0>(a.ffn_w_down, FF, DM, nullptr, Wd0_t, 0, scr, gw, ngw, lane);
        convert_matrix<0>(a.ffn_w_down + (size_t)FF * DM, FF, DM, nullptr, Wd1_t, 0, scr, gw, ngw, lane);
        convert_matrix<0>(a.b_w_q, DM, DM, a.b_norm, Wqkv_t, 0, scr, gw, ngw, lane);
        convert_matrix<0>(a.w_kv, DM, 2 * DM, a.kv_norm, Wqkv_t, DM, scr, gw, ngw, lane);
        convert_matrix<0>(a.b_w_o, DM, DM, nullptr, Wo_t, 0, scr, gw, ngw, lane);
        for (int m = gw; m < MT; m += 2 * ngw) {
            const int m1 = m + ngw;
            const bool two = m1 < MT;
            const f32x4* xr0 = (const f32x4*)(a.x + (size_t)m * DM) + lane; const f32x4* xr1 = (const f32x4*)(a.x + (size_t)(two ? m1 : m) * DM) + lane;
            f32x4 v0[4], v1[4]; float s0 = 0.f, s1 = 0.f;
#pragma unroll
            for (int j = 0; j < 4; ++j) { v0[j] = xr0[64 * j]; v1[j] = xr1[64 * j]; }
#pragma unroll
            for (int j = 0; j < 4; ++j) { s0 += (v0[j].x * v0[j].x + v0[j].y * v0[j].y) + (v0[j].z * v0[j].z + v0[j].w * v0[j].w); s1 += (v1[j].x * v1[j].x + v1[j].y * v1[j].y) + (v1[j].z * v1[j].z + v1[j].w * v1[j].w); }
            const float r0 = __builtin_amdgcn_rsqf(wave_sum(s0) * (1.0f / DM) + RMS_EPS), r1 = __builtin_amdgcn_rsqf(wave_sum(s1) * (1.0f / DM) + RMS_EPS);
            v2u* o0 = (v2u*)(XN + (size_t)m * DM) + lane; v2u* o1 = (v2u*)(XN + (size_t)m1 * DM) + lane;
#pragma unroll
            for (int j = 0; j < 4; ++j) { const f32x4 gn = ((const f32x4*)a.a_norm)[lane + 64 * j];
                v2u w; w.x = pk2(v0[j].x * r0 * gn.x, v0[j].y * r0 * gn.y); w.y = pk2(v0[j].z * r0 * gn.z, v0[j].w * r0 * gn.w); o0[64 * j] = w;
                if (two) { v2u w1; w1.x = pk2(v1[j].x * r1 * gn.x, v1[j].y * r1 * gn.y); w1.y = pk2(v1[j].z * r1 * gn.z, v1[j].w * r1 * gn.w); o1[64 * j] = w1; } }
        }
    }
    grid.sync();
    PH(1) { PHASE_ARGS() pg8::EpiWin E{Bg, CH}; run_gemm(lds, XN, Win_t, 3 * DM, DM, E); }
    GRID_BAR();
    PH(2) { PHASE_ARGS()
        const int total = (MT / 8) * (DM / 8);
        const float* cw = a.a_conv;
        for (int it = gtid; it < total; it += gthreads) { const int cg8 = (it % (DM / 8)) * 8, t0 = (it / (DM / 8)) * 8;
            float w0[8], w1[8], w2[8];
#pragma unroll
            for (int i = 0; i < 8; ++i) { w0[i] = cw[cg8 + i]; w1[i] = cw[DM + cg8 + i]; w2[i] = cw[2 * DM + cg8 + i]; }
            float p2[8], p1[8];
            if ((t0 & (SEQ - 1)) == 0) {
#pragma unroll
                for (int i = 0; i < 8; ++i) { p2[i] = 0.f; p1[i] = 0.f; }
            } else { const v4u a2 = *(const v4u*)(CH + (size_t)(t0 - 2) * DM + cg8), a1 = *(const v4u*)(CH + (size_t)(t0 - 1) * DM + cg8);
                p2[0] = bflo(a2.x); p2[1] = bfhi(a2.x); p2[2] = bflo(a2.y); p2[3] = bfhi(a2.y); p2[4] = bflo(a2.z); p2[5] = bfhi(a2.z); p2[6] = bflo(a2.w); p2[7] = bfhi(a2.w);
                p1[0] = bflo(a1.x); p1[1] = bfhi(a1.x); p1[2] = bflo(a1.y); p1[3] = bfhi(a1.y); p1[4] = bflo(a1.z); p1[5] = bfhi(a1.z); p1[6] = bflo(a1.w); p1[7] = bfhi(a1.w); }
            v4u c4a[8], b4a[8];
#pragma unroll
            for (int t = 0; t < 8; ++t) { const size_t off = (size_t)(t0 + t) * DM + cg8; c4a[t] = *(const v4u*)(CH + off); b4a[t] = *(const v4u*)(Bg + off); }
#pragma unroll
            for (int t = 0; t < 8; ++t) { const size_t off = (size_t)(t0 + t) * DM + cg8; const v4u c4 = c4a[t], b4 = b4a[t];
                float c[8], bgt[8], y[8];
                c[0] = bflo(c4.x); c[1] = bfhi(c4.x); c[2] = bflo(c4.y); c[3] = bfhi(c4.y); c[4] = bflo(c4.z); c[5] = bfhi(c4.z); c[6] = bflo(c4.w); c[7] = bfhi(c4.w);
                bgt[0] = bflo(b4.x); bgt[1] = bfhi(b4.x); bgt[2] = bflo(b4.y); bgt[3] = bfhi(b4.y); bgt[4] = bflo(b4.z); bgt[5] = bfhi(b4.z); bgt[6] = bflo(b4.w); bgt[7] = bfhi(b4.w);
#pragma unroll
                for (int i = 0; i < 8; ++i) { y[i] = bgt[i] * (w2[i] * c[i] + w1[i] * p1[i] + w0[i] * p2[i]); p2[i] = p1[i]; p1[i] = c[i]; }
                v4u o; o.x = pk2(y[0], y[1]); o.y = pk2(y[2], y[3]); o.z = pk2(y[4], y[5]); o.w = pk2(y[6], y[7]); *(v4u*)(Y + off) = o; }
        }
    }
    GRID_BAR();
    PH(3) { PHASE_ARGS() pg8::EpiRes<true> E{a.x, XN, SS1}; run_gemm(lds, Y, Wout_t, DM, DM, E); }
    GRID_BAR();
    PH(4) { PHASE_ARGS() pg8::EpiFfnUp E{ACT, EB, SS1, a.ffn_conv, a.ffn_conv_b}; run_gemm(lds, XN, Wup0_t, FF2, DM, E); }
    GRID_BAR();
    PH(5) { PHASE_ARGS() ffn_fixup(EB, a.ffn_conv, a.ffn_conv_b, ACT, gtid, gthreads); }
    GRID_BAR();
    PH(6) { PHASE_ARGS() pg8::EpiRes<false> E{nullptr, XN, SS2}; run_gemm(lds, ACT, Wd0_t, DM, FF, E); }
    GRID_BAR();
    PH(7) { PHASE_ARGS() pg8::EpiQKV E{Qb, SS2, 0.125f * LOG2E}; run_gemm(lds, XN, Wqkv_t, 3 * DM, DM, E); }
    GRID_BAR();
    PH(8) { PHASE_ARGS()
        att::Bufs B{Qb, Kb, Vb, a.rel_bias, O1, O2, ST1, ST2, OF};
        att::attn_phase<false>(lds, B);
    }
    GRID_BAR();
    PH(9) { PHASE_ARGS()
        att::Bufs B{Qb, Kb, Vb, a.rel_bias, O1, O2, ST1, ST2, OF};
        att::attn_phase<true>(lds, B);
    }
    GRID_BAR();
    PH(10) { PHASE_ARGS() pg8::EpiRes<false> E{nullptr, XN, SS3}; run_gemm(lds, OF, Wo_t, DM, DM, E); }
    GRID_BAR();
    PH(11) { PHASE_ARGS() pg8::EpiFfnUp E{ACT, EB, SS3, a.ffn_conv + 3 * FF2, a.ffn_conv_b + FF2}; run_gemm(lds, XN, Wup1_t, FF2, DM, E); }
    GRID_BAR();
    PH(12) { PHASE_ARGS() ffn_fixup(EB, a.ffn_conv + 3 * FF2, a.ffn_conv_b + FF2, ACT, gtid, gthreads); }
    GRID_BAR();
    PH(13) { PHASE_ARGS() pg8::EpiRes<false> E{nullptr, XN, SS4}; run_gemm(lds, ACT, Wd1_t, DM, FF, E); }
    GRID_BAR();
    PH(14) { PHASE_ARGS() for (int m0 = gw; m0 < MT; m0 += 4 * ngw) {
        v4u hb[4][2]; float rs[4];
#pragma unroll
        for (int r = 0; r < 4; ++r) { const int m = m0 + r * ngw < MT ? m0 + r * ngw : m0; const v4u* hr = (const v4u*)(XN + (size_t)m * DM) + lane; hb[r][0] = hr[0]; hb[r][1] = hr[64]; rs[r] = pg8::row_rstd(SS4, m); }
#pragma unroll
        for (int r = 0; r < 4; ++r) { const int m = m0 + r * ngw; if (m < MT) { f32x4* xr = (f32x4*)(a.out + (size_t)m * DM);
#pragma unroll
            for (int j = 0; j < 2; ++j) { const v4u h = hb[r][j]; const int c = (lane + 64 * j) * 8; const float s = rs[r];
                const f32x4 g0 = *(const f32x4*)(a.final_norm + c), g1 = *(const f32x4*)(a.final_norm + c + 4);
                xr[(c >> 2)] = (f32x4){bflo(h.x) * s * g0.x, bfhi(h.x) * s * g0.y, bflo(h.y) * s * g0.z, bfhi(h.y) * s * g0.w};
                xr[(c >> 2) + 1] = (f32x4){bflo(h.z) * s * g1.x, bfhi(h.z) * s * g1.y, bflo(h.w) * s * g1.z, bfhi(h.w) * s * g1.w}; } } }
    } }
}

#undef a
extern "C" void kernel_launch(void* const* d_in, const int* in_sizes, int n_in, void* d_out, int out_size, void* d_ws, size_t ws_size, hipStream_t stream) {
    static int grid = 0;
    if (grid == 0) {
        if (n_in != 17 || in_sizes[0] != MT * DM || out_size != MT * DM || ws_size < WS_END) { fprintf(stderr, "kernel_launch: unexpected shapes (n_in %d, in0 %d, out %d, ws %zu)\n", n_in, n_in > 0 ? in_sizes[0] : -1, out_size, ws_size); grid = -1; return; }
        int dev = 0, cus = 0, per_cu = 0;
        hipGetDevice(&dev); hipDeviceGetAttribute(&cus, hipDeviceAttributeMultiprocessorCount, dev);
        if (hipFuncSetAttribute((const void*)yoco_fwd, hipFuncAttributeMaxDynamicSharedMemorySize, LDS_BYTES) != hipSuccess) { fprintf(stderr, "kernel_launch: hipFuncSetAttribute failed\n"); grid = -1; return; }
        if (hipOccupancyMaxActiveBlocksPerMultiprocessor(&per_cu, (const void*)yoco_fwd, NTHREADS, LDS_BYTES) != hipSuccess || per_cu < 1) { fprintf(stderr, "kernel_launch: occupancy query says %d\n", per_cu); per_cu = 1; }
        (void)hipGetLastError();
        grid = cus * 1;
    }
    if (grid < 0) return;
    Args a{};
    a.x = (const float*)d_in[0]; a.a_norm = (const float*)d_in[1]; a.a_w_in = (const float*)d_in[2]; a.a_conv = (const float*)d_in[3]; a.a_w_out = (const float*)d_in[4];
    a.kv_norm = (const float*)d_in[5]; a.w_kv = (const float*)d_in[6]; a.b_norm = (const float*)d_in[7]; a.b_w_q = (const float*)d_in[8]; a.b_w_o = (const float*)d_in[9];
    a.rel_bias = (const float*)d_in[10]; a.ffn_norm = (const float*)d_in[11]; a.ffn_w_up = (const float*)d_in[12]; a.ffn_conv = (const float*)d_in[13]; a.ffn_conv_b = (const float*)d_in[14];
    a.ffn_w_down = (const float*)d_in[15]; a.final_norm = (const float*)d_in[16];
    a.out = (float*)d_out; a.ws = (unsigned char*)d_ws;
    if (hipMemsetAsync((char*)d_ws + WS_BAR, 0, WS_BAR_BYTES, stream) != hipSuccess) { fprintf(stderr, "kernel_launch: memset of the barrier words failed\n"); return; }
    void* args[] = {&a};
    hipError_t e = hipLaunchCooperativeKernel((const void*)yoco_fwd, dim3(grid), dim3(NTHREADS), args, LDS_BYTES, stream);
    if (e != hipSuccess) fprintf(stderr, "cooperative launch failed: %s (grid %d)\n", hipGetErrorString(e), grid);
}
```

```cpp
#include <hip/hip_runtime.h>
#include <hip/hip_cooperative_groups.h>
#include <cstdio>
#include <cstdint>
namespace cg = cooperative_groups;

constexpr int DM = 1024, NB = 16, SEQ = 4096, MT = NB * SEQ  , NH = 16, HD = 64, FF = 2816, FF2 = 2 * FF;
constexpr float RMS_EPS = 1e-6f;
constexpr float LOG2E = 1.4426950408889634f;

namespace pg8 {
#define PG8_LAS __attribute__((address_space(3)))
typedef unsigned short bf16_t;
typedef short bf16x8 __attribute__((ext_vector_type(8)));
typedef float f32x4 __attribute__((ext_vector_type(4)));
typedef unsigned u32x4 __attribute__((ext_vector_type(4)));
constexpr int BM = 256, BK = 64, HALF = 128, HTB = HALF * BK * 2  , STAGE_BYTES = 8 * HTB, NXCD = 8, WGM = 8;

__host__ __device__ __forceinline__ int lds_byte(int r, int c) { const int st = (r >> 4) * 2 + (c >> 5), rr = r & 15, cc = c & 31, ob = rr * 64 + cc * 2; return st * 1024 + (ob ^ (((ob >> 9) & 1) << 5)); }
__host__ __device__ __forceinline__ void stage_rc(int b, int& R, int& C) { const int st = b / 1024, sb = b % 1024, swz = sb ^ (((sb >> 9) & 1) << 5); R = (st >> 1) * 16 + swz / 64; C = (st & 1) * 32 + (swz % 64) / 2; }
__host__ __device__ __forceinline__ int perm32(int rho) { const int n = rho >> 4, i = rho & 15; return 8 * (i >> 2) + 4 * n + (i & 3); }

struct Unit { int pm, pn; };
struct Gemm { const bf16_t* A; const bf16_t* Bt; int M, N, K; };

struct StaticOrder {
    int nM, nN, nwg, G, c;
    __host__ __device__ void init(int M, int N, int G_, int c_) { nM = M / BM; nN = N / BM; nwg = nM * nN; G = G_; c = c_; }
    __host__ __device__ bool next(int i, Unit& u) const {
        const long L = (long)i * G + c; if (L >= nwg) return false;
        int wgid = (int)L; { const int q = nwg / NXCD, r = nwg % NXCD, xcd = wgid % NXCD, off = wgid / NXCD; wgid = (xcd < r ? xcd * (q + 1) : r * (q + 1) + (xcd - r) * q) + off; }
        const int nig = WGM * nN, gid = wgid / nig, fm = gid * WGM, gsz = (nM - fm) < WGM ? (nM - fm) : WGM;
        u.pm = fm + ((wgid % nig) % gsz); u.pn = (wgid % nig) / gsz; return true;
    }
    __device__ __forceinline__ void a_ready(const Unit&) const {}
    __device__ __forceinline__ void done(const Unit&) const {}
};

typedef float f32x2_c __attribute__((ext_vector_type(2))); typedef __bf16 bf16x2_c __attribute__((ext_vector_type(2)));
__device__ __forceinline__ unsigned cvt_pk_bf16(float lo, float hi) { const f32x2_c v = {lo, hi}; const bf16x2_c b = __builtin_convertvector(v, bf16x2_c); return __builtin_bit_cast(unsigned, b); }
__device__ __forceinline__ float row_rstd(const float* SS, int row) {
    const f32x4 p = *(const f32x4*)(SS + (size_t)row * 4);
    const float s = (p[0] + p[1]) + (p[2] + p[3]);
    return __builtin_amdgcn_rsqf(s * (1.0f / DM) + RMS_EPS);
}
#define EPI_ARGS f32x4 (&acc)[2][2][4][2], const Unit& u, int wr, int wc, int fr, int fq, PG8_LAS unsigned char* ldsx, int ui, int wid, int lane

struct EpiWin {
    static constexpr bool PERM = true, AFTER_DRAIN = false;
    bf16_t* Bg; bf16_t* CH;
    __device__ __forceinline__ void operator()(EPI_ARGS) const {
        const int row0 = u.pm * BM + wr * 64 + fr;
        if (u.pn < 4) {
            const int col0 = u.pn * BM + wc * 32 + 8 * fq;
#pragma unroll
            for (int ai = 0; ai < 2; ++ai)
#pragma unroll
                for (int m = 0; m < 4; ++m) { bf16_t* rowp = Bg + (size_t)(row0 + ai * HALF + m * 16) * DM + col0;
#pragma unroll
                    for (int bj = 0; bj < 2; ++bj) { const f32x4 v0 = acc[ai][bj][m][0], v1 = acc[ai][bj][m][1];
                        u32x4 w; w.x = cvt_pk_bf16(v0[0], v0[1]); w.y = cvt_pk_bf16(v0[2], v0[3]); w.z = cvt_pk_bf16(v1[0], v1[1]); w.w = cvt_pk_bf16(v1[2], v1[3]);
                        __builtin_nontemporal_store(w, (u32x4*)(rowp + bj * HALF)); } }
        } else {
            const int col0 = (u.pn - 4) * HALF + wc * 32 + 8 * fq;
#pragma unroll
            for (int ai = 0; ai < 2; ++ai)
#pragma unroll
                for (int m = 0; m < 4; ++m) { bf16_t* rowp = CH + (size_t)(row0 + ai * HALF + m * 16) * DM + col0;
                    const f32x4 v0 = acc[ai][0][m][0] * acc[ai][1][m][0], v1 = acc[ai][0][m][1] * acc[ai][1][m][1];
                    u32x4 w; w.x = cvt_pk_bf16(v0[0], v0[1]); w.y = cvt_pk_bf16(v0[2], v0[3]); w.z = cvt_pk_bf16(v1[0], v1[1]); w.w = cvt_pk_bf16(v1[2], v1[3]);
                    __builtin_nontemporal_store(w, (u32x4*)rowp); }
        }
    }
};

struct EpiQKV {
    static constexpr bool PERM = true, AFTER_DRAIN = false;
    bf16_t* QKV; const float* SS; float qscale;
    __device__ __forceinline__ void operator()(EPI_ARGS) const {
        const int row0 = u.pm * BM + wr * 64 + fr; const int t = u.pn >> 2;
        bf16_t* base = QKV + (size_t)t * MT * DM; const float sc = t == 0 ? qscale : 1.0f;
        const int head0 = (u.pn & 3) * 4 + (wc >> 1), d0 = (wc & 1) * 32 + 8 * fq;
        float rsv[2][4];
#pragma unroll
        for (int ai = 0; ai < 2; ++ai)
#pragma unroll
            for (int m = 0; m < 4; ++m) rsv[ai][m] = row_rstd(SS, row0 + ai * HALF + m * 16) * sc;
#pragma unroll
        for (int ai = 0; ai < 2; ++ai)
#pragma unroll
            for (int m = 0; m < 4; ++m) { const int row = row0 + ai * HALF + m * 16; const float rs = rsv[ai][m]; const int bb = row >> 12, tt = row & (SEQ - 1);
#pragma unroll
                for (int bj = 0; bj < 2; ++bj) { const f32x4 v0 = acc[ai][bj][m][0] * rs, v1 = acc[ai][bj][m][1] * rs;
                    u32x4 w; w.x = cvt_pk_bf16(v0[0], v0[1]); w.y = cvt_pk_bf16(v0[2], v0[3]); w.z = cvt_pk_bf16(v1[0], v1[1]); w.w = cvt_pk_bf16(v1[2], v1[3]);
                    __builtin_nontemporal_store(w, (u32x4*)(base + ((size_t)(bb * NH + head0 + 2 * bj) * SEQ + tt) * HD + d0)); } }
    }
};

__device__ __forceinline__ float bf2f_lo(unsigned w) { return __builtin_bit_cast(float, w << 16); }
__device__ __forceinline__ float bf2f_hi(unsigned w) { return __builtin_bit_cast(float, w & 0xffff0000u); }
template <bool BASE_F32> struct EpiRes {
    static constexpr bool PERM = true, AFTER_DRAIN = false;
    const float* basef; bf16_t* Hb; float* SS;
    __device__ __forceinline__ void operator()(EPI_ARGS) const {
        PG8_LAS float* red = (PG8_LAS float*)(ldsx + (ui & 1) * 8192);
        const int row0 = u.pm * BM + wr * 64 + fr; const int col0 = u.pn * BM + wc * 32 + 8 * fq;
        if (BASE_F32) {
#pragma unroll
            for (int ai = 0; ai < 2; ++ai) {
                f32x4 b0[4][2], b1[4][2];
#pragma unroll
                for (int m = 0; m < 4; ++m) { const size_t off = (size_t)(row0 + ai * HALF + m * 16) * DM + col0;
#pragma unroll
                    for (int bj = 0; bj < 2; ++bj) { b0[m][bj] = *(const f32x4*)(basef + off + bj * HALF); b1[m][bj] = *(const f32x4*)(basef + off + bj * HALF + 4); } }
#pragma unroll
                for (int m = 0; m < 4; ++m) { const size_t off = (size_t)(row0 + ai * HALF + m * 16) * DM + col0; float ssq = 0.f;
#pragma unroll
                    for (int bj = 0; bj < 2; ++bj) {
                        const f32x4 v0 = acc[ai][bj][m][0] + b0[m][bj], v1 = acc[ai][bj][m][1] + b1[m][bj];
                        ssq += (v0[0] * v0[0] + v0[1] * v0[1]) + (v0[2] * v0[2] + v0[3] * v0[3]) + (v1[0] * v1[0] + v1[1] * v1[1]) + (v1[2] * v1[2] + v1[3] * v1[3]);
                        u32x4 w; w.x = cvt_pk_bf16(v0[0], v0[1]); w.y = cvt_pk_bf16(v0[2], v0[3]); w.z = cvt_pk_bf16(v1[0], v1[1]); w.w = cvt_pk_bf16(v1[2], v1[3]);
                        __builtin_nontemporal_store(w, (u32x4*)(Hb + off + bj * HALF)); }
                    ssq += __shfl_xor(ssq, 16); ssq += __shfl_xor(ssq, 32);
                    if (fq == 0) red[wc * 256 + ai * HALF + wr * 64 + m * 16 + fr] = ssq; }
            }
        } else {
            u32x4 hb[2][4][2];
#pragma unroll
            for (int ai = 0; ai < 2; ++ai)
#pragma unroll
                for (int m = 0; m < 4; ++m) { const size_t off = (size_t)(row0 + ai * HALF + m * 16) * DM + col0;
#pragma unroll
                    for (int bj = 0; bj < 2; ++bj) hb[ai][m][bj] = *(const u32x4*)(Hb + off + bj * HALF); }
#pragma unroll
            for (int ai = 0; ai < 2; ++ai)
#pragma unroll
                for (int m = 0; m < 4; ++m) { const size_t off = (size_t)(row0 + ai * HALF + m * 16) * DM + col0; float ssq = 0.f;
#pragma unroll
                    for (int bj = 0; bj < 2; ++bj) { const u32x4 h = hb[ai][m][bj];
                        const f32x4 b0 = (f32x4){bf2f_lo(h.x), bf2f_hi(h.x), bf2f_lo(h.y), bf2f_hi(h.y)}, b1 = (f32x4){bf2f_lo(h.z), bf2f_hi(h.z), bf2f_lo(h.w), bf2f_hi(h.w)};
                        const f32x4 v0 = acc[ai][bj][m][0] + b0, v1 = acc[ai][bj][m][1] + b1;
                        ssq += (v0[0] * v0[0] + v0[1] * v0[1]) + (v0[2] * v0[2] + v0[3] * v0[3]) + (v1[0] * v1[0] + v1[1] * v1[1]) + (v1[2] * v1[2] + v1[3] * v1[3]);
                        u32x4 w; w.x = cvt_pk_bf16(v0[0], v0[1]); w.y = cvt_pk_bf16(v0[2], v0[3]); w.z = cvt_pk_bf16(v1[0], v1[1]); w.w = cvt_pk_bf16(v1[2], v1[3]);
                        __builtin_nontemporal_store(w, (u32x4*)(Hb + off + bj * HALF)); }
                    ssq += __shfl_xor(ssq, 16); ssq += __shfl_xor(ssq, 32);
                    if (fq == 0) red[wc * 256 + ai * HALF + wr * 64 + m * 16 + fr] = ssq; }
        }
        asm volatile("s_waitcnt lgkmcnt(0)" ::: "memory"); __builtin_amdgcn_s_barrier(); asm volatile("" ::: "memory");
        const int tid = wid * 64 + lane;
        if (tid < 256) { const float s = (red[tid] + red[256 + tid]) + (red[512 + tid] + red[768 + tid]); SS[(size_t)(u.pm * BM + tid) * 4 + u.pn] = s; }
    }
};

__device__ __forceinline__ void conv_cur2(float& u0, float& u1, float x0, float x1, float w1a, float w1b, float w0a, float w0b) {
    asm volatile("s_nop 1\n\tv_fmac_f32_dpp %0, %2, %4 row_shr:1 row_mask:0xf bank_mask:0xf bound_ctrl:1\n\tv_fmac_f32_dpp %1, %3, %5 row_shr:1 row_mask:0xf bank_mask:0xf bound_ctrl:1\n\t"
                 "v_fmac_f32_dpp %0, %2, %6 row_shr:2 row_mask:0xf bank_mask:0xf bound_ctrl:1\n\tv_fmac_f32_dpp %1, %3, %7 row_shr:2 row_mask:0xf bank_mask:0xf bound_ctrl:1"
                 : "+v"(u0), "+v"(u1) : "v"(x0), "v"(x1), "v"(w1a), "v"(w1b), "v"(w0a), "v"(w0b));
}
__device__ __forceinline__ void conv_prev2(float& u0, float& u1, float p0, float p1, float c1a, float c1b, float c2a, float c2b) {
    asm volatile("s_nop 1\n\tv_fmac_f32_dpp %0, %2, %4 row_ror:1 row_mask:0xf bank_mask:0xf\n\tv_fmac_f32_dpp %1, %3, %5 row_ror:1 row_mask:0xf bank_mask:0xf\n\t"
                 "v_fmac_f32_dpp %0, %2, %6 row_ror:2 row_mask:0xf bank_mask:0xf\n\tv_fmac_f32_dpp %1, %3, %7 row_ror:2 row_mask:0xf bank_mask:0xf"
                 : "+v"(u0), "+v"(u1) : "v"(p0), "v"(p1), "v"(c1a), "v"(c1b), "v"(c2a), "v"(c2b));
}
__device__ __forceinline__ float silu_f(float g) { return g * __builtin_amdgcn_rcpf(1.0f + __builtin_amdgcn_exp2f(-g * LOG2E)); }

struct EpiFfnUp {
    static constexpr bool PERM = true, AFTER_DRAIN = false;
    bf16_t* ACT; float* E; const float* SS; const float* cw; const float* cb;
    __device__ __forceinline__ void operator()(f32x4 (&acc)[2][2][4][2], const Unit& u, int wr, int wc, int fr_in, int fq_in, PG8_LAS unsigned char* ldsx, int ui, int wid, int lane_in) const {
        int lane = lane_in; asm volatile("" : "+v"(lane));
        const int fr = lane & 15, fq = lane >> 4; (void)fr_in; (void)fq_in;
        PG8_LAS float* H = (PG8_LAS float*)(ldsx + (ui & 1) * 12288);
        PG8_LAS float* CW = H + 2048;
        const int row0 = u.pm * BM + wr * 64 + fr; const int ct0 = wc * 32 + 8 * fq;
        float cwv0, cwv1;
        { const int t = wid * 64 + lane, c = t & 255, arr = (t >> 8) * 2; const int oc = (c >> 7) * FF + u.pn * HALF + (c & 127);
          cwv0 = arr == 0 ? cw[oc] : cw[2 * FF2 + oc]; cwv1 = arr == 0 ? cw[FF2 + oc] : cb[oc]; }
        float rs[2][4];
#pragma unroll
        for (int ai = 0; ai < 2; ++ai)
#pragma unroll
            for (int m = 0; m < 4; ++m) rs[ai][m] = row_rstd(SS, row0 + ai * HALF + m * 16);
        { const int t = wid * 64 + lane, c = t & 255, arr = (t >> 8) * 2; CW[arr * 256 + c] = cwv0; CW[(arr + 1) * 256 + c] = cwv1; }
#pragma unroll
        for (int ai = 0; ai < 2; ++ai)
#pragma unroll
            for (int m = 0; m < 4; ++m) {
#pragma unroll
                for (int bj = 0; bj < 2; ++bj)
#pragma unroll
                    for (int n = 0; n < 2; ++n) acc[ai][bj][m][n] = acc[ai][bj][m][n] * rs[ai][m];
                asm volatile("" : "+v"(acc[ai][0][m][0]), "+v"(acc[ai][0][m][1]), "+v"(acc[ai][1][m][0]), "+v"(acc[ai][1][m][1])); }
        if (fr >= 14) {
#pragma unroll
            for (int ai = 0; ai < 2; ++ai)
#pragma unroll
                for (int bj = 0; bj < 2; ++bj)
#pragma unroll
                    for (int n = 0; n < 2; ++n) *(PG8_LAS f32x4*)(H + ((2 * ai + wr) * 2 + (fr - 14)) * 256 + bj * HALF + ct0 + 4 * n) = acc[ai][bj][3][n];
        }
        { int fre = fr, cte = ct0; asm volatile("" : "+v"(fre), "+v"(cte));
          float* Ep = E + (size_t)u.pm * 4 * FF2 + (size_t)u.pn * BM + cte;
          if (wr == 0 && fre < 2) {
#pragma unroll
              for (int bj = 0; bj < 2; ++bj)
#pragma unroll
                  for (int n = 0; n < 2; ++n) *(f32x4*)(Ep + (size_t)fre * FF2 + bj * HALF + 4 * n) = acc[0][bj][0][n]; }
          if (wr == 1 && fre >= 14) {
#pragma unroll
              for (int bj = 0; bj < 2; ++bj)
#pragma unroll
                  for (int n = 0; n < 2; ++n) *(f32x4*)(Ep + (size_t)(fre - 12) * FF2 + bj * HALF + 4 * n) = acc[1][bj][3][n]; } }
        asm volatile("s_waitcnt lgkmcnt(0)" ::: "memory"); __builtin_amdgcn_s_barrier(); asm volatile("" ::: "memory");
        const int oc0 = u.pn * HALF + ct0;
#pragma unroll
        for (int bj = 0; bj < 2; ++bj)
#pragma unroll
            for (int n = 0; n < 2; ++n) {
                const int cc = bj * HALF + ct0 + 4 * n;
                const f32x4 w0 = *(const PG8_LAS f32x4*)(CW + cc), w1 = *(const PG8_LAS f32x4*)(CW + 256 + cc), w2 = *(const PG8_LAS f32x4*)(CW + 512 + cc), bb = *(const PG8_LAS f32x4*)(CW + 768 + cc);
                f32x4 c1, c2;
#pragma unroll
                for (int i = 0; i < 4; ++i) { c1[i] = fr == 0 ? w1[i] : 0.f; c2[i] = fr < 2 ? w0[i] : 0.f; }
#pragma unroll
                for (int ai = 0; ai < 2; ++ai) {
#pragma unroll
                    for (int m = 3; m >= 0; --m) {
                        const f32x4 cur = acc[ai][bj][m][n];
                        const f32x4 ui4 = w2 * cur + bb; float u0 = ui4[0], u1 = ui4[1], u2 = ui4[2], u3 = ui4[3];
                        conv_cur2(u0, u1, cur[0], cur[1], w1[0], w1[1], w0[0], w0[1]);
                        conv_cur2(u2, u3, cur[2], cur[3], w1[2], w1[3], w0[2], w0[3]);
                        if (m > 0) {
                            const f32x4 prev = acc[ai][bj][m - 1][n];
                            conv_prev2(u0, u1, prev[0], prev[1], c1[0], c1[1], c2[0], c2[1]);
                            conv_prev2(u2, u3, prev[2], prev[3], c1[2], c1[3], c2[2], c2[3]);
                        }
                        f32x4 uu = (f32x4){u0, u1, u2, u3};
                        if (m == 0) {
                            const int q = 2 * ai + wr;
                            if (q != 0) { const f32x4 h63 = *(const PG8_LAS f32x4*)(H + ((q - 1) * 2 + 1) * 256 + bj * HALF + ct0 + 4 * n), h62 = *(const PG8_LAS f32x4*)(H + ((q - 1) * 2 + 0) * 256 + bj * HALF + ct0 + 4 * n);
#pragma unroll
                                for (int i = 0; i < 4; ++i) uu[i] += c1[i] * h63[i] + c2[i] * (fr == 0 ? h62[i] : h63[i]); }
                        }
                        acc[ai][bj][m][n] = uu;
                        asm volatile("" : "+v"(acc[ai][bj][m][n]));
                        __builtin_amdgcn_sched_barrier(0);
                    }
                }
            }
#pragma unroll
        for (int ai = 0; ai < 2; ++ai)
#pragma unroll
            for (int m = 0; m < 4; ++m) { bf16_t* rowp = ACT + (size_t)(row0 + ai * HALF + m * 16) * FF + oc0;
                f32x4 a0, a1;
#pragma unroll
                for (int i = 0; i < 4; ++i) { a0[i] = silu_f(acc[ai][0][m][0][i]) * acc[ai][1][m][0][i]; a1[i] = silu_f(acc[ai][0][m][1][i]) * acc[ai][1][m][1][i]; }
                u32x4 w; w.x = cvt_pk_bf16(a0[0], a0[1]); w.y = cvt_pk_bf16(a0[2], a0[3]); w.z = cvt_pk_bf16(a1[0], a1[1]); w.w = cvt_pk_bf16(a1[2], a1[3]);
                __builtin_nontemporal_store(w, (u32x4*)rowp); }
    }
};

template <class Epi, class Sched, bool ALIGN_EPI = false, bool SP2 = false>
__device__ __forceinline__ void gemm_phase(PG8_LAS unsigned char* lds, PG8_LAS unsigned char* ldsx, const Gemm g, const Sched& S, const Epi& E) {
    int tid_ = threadIdx.x; asm volatile("" : "+v"(tid_));
    const int tid = tid_, wid = __builtin_amdgcn_readfirstlane(tid >> 6), lane = tid & 63, wr = wid >> 2, wc = wid & 3, fr = lane & 15, fq = lane >> 4;
    const int K = g.K, nt = K / BK;
    unsigned voffA[2], voffB[2];
#pragma unroll
    for (int i = 0; i < 2; ++i) { int R, C; stage_rc(tid * 16 + i * 8192, R, C); const int Rb = Epi::PERM ? ((R & ~31) + perm32(R & 31)) : R;
        voffA[i] = (unsigned)(R * K + C) * 2u; voffB[i] = (unsigned)(Rb * K + C) * 2u; }
    const size_t kstep = (size_t)(BK * 2);
    const size_t hstep = (size_t)HALF * K * 2;
    const size_t tstep = 2 * hstep;
    const unsigned ldsw = (unsigned)wid * 1024u;
    const int aoff = lds_byte(wr * 64 + fr, fq * 8), boff = lds_byte(wc * 32 + fr, fq * 8);
#define PG8_SA(b, h) (((b) * 2 + (h)) * HTB)
#define PG8_SB(b, h) ((4 + (b) * 2 + (h)) * HTB)
#define PG8_STAGE(bufoff, gbase, voff) do { _Pragma("unroll") for (int _i = 0; _i < 2; ++_i) \
        __builtin_amdgcn_global_load_lds((const unsigned*)((const char*)(gbase) + (voff)[_i]), (PG8_LAS unsigned*)(lds + (bufoff) + ldsw + _i * 8192), 16, 0, 0); } while (0)
#define PG8_LDA(dst, b, h) do { _Pragma("unroll") for (int m = 0; m < 4; ++m) _Pragma("unroll") for (int k = 0; k < 2; ++k) dst[m][k] = *(const PG8_LAS bf16x8*)(lds + PG8_SA(b, h) + aoff + m * 2048 + k * 1024); } while (0)
#define PG8_LDB(dst, b, h) do { _Pragma("unroll") for (int n = 0; n < 2; ++n) _Pragma("unroll") for (int k = 0; k < 2; ++k) dst[n][k] = *(const PG8_LAS bf16x8*)(lds + PG8_SB(b, h) + boff + n * 2048 + k * 1024); } while (0)
#define PG8_MMA(ai, bj, At, Bt) do { __builtin_amdgcn_s_setprio(1); _Pragma("unroll") for (int m = 0; m < 4; ++m) _Pragma("unroll") for (int n = 0; n < 2; ++n) _Pragma("unroll") for (int k = 0; k < 2; ++k) \
        acc[ai][bj][m][n] = __builtin_amdgcn_mfma_f32_16x16x32_bf16(Bt[n][k], At[m][k], acc[ai][bj][m][n], 0, 0, 0); __builtin_amdgcn_s_setprio(0); } while (0)
#define PG8_WAIT_V(n) asm volatile("s_waitcnt vmcnt(" #n ")" ::: "memory")
#define PG8_WAIT_L(n) asm volatile("s_waitcnt lgkmcnt(" #n ")" ::: "memory")
#define PG8_BAR __builtin_amdgcn_s_barrier()
#define PG8_SCHED __builtin_amdgcn_sched_barrier(0)
    Unit cur, nxt; int ui = 0;
    if (!S.next(0, cur)) return;
    f32x4 acc[2][2][4][2];
#pragma unroll
    for (int a = 0; a < 2; ++a)
#pragma unroll
        for (int b = 0; b < 2; ++b)
#pragma unroll
            for (int m = 0; m < 4; ++m)
#pragma unroll
                for (int n = 0; n < 2; ++n) acc[a][b][m][n] = (f32x4){0.f, 0.f, 0.f, 0.f};
    bf16x8 At[4][2], B0[2][2], B1[2][2];
    const char* cA = (const char*)g.A + (size_t)cur.pm * tstep; const char* cB = (const char*)g.Bt + (size_t)cur.pn * tstep;
    S.a_ready(cur);
    if constexpr (SP2) {
        PG8_STAGE(PG8_SB(0, 0), cB, voffB); PG8_STAGE(PG8_SB(0, 1), cB + hstep, voffB); PG8_STAGE(PG8_SA(0, 0), cA, voffA); PG8_STAGE(PG8_SA(0, 1), cA + hstep, voffA);
        if (wr == 1) PG8_BAR;
        PG8_WAIT_V(2); PG8_BAR;
        PG8_STAGE(PG8_SB(1, 0), cB + kstep, voffB); PG8_STAGE(PG8_SA(1, 0), cA + kstep, voffA); PG8_STAGE(PG8_SB(1, 1), cB + hstep + kstep, voffB);
        PG8_WAIT_V(6); PG8_BAR;
    } else {
        PG8_STAGE(PG8_SB(0, 0), cB, voffB); PG8_STAGE(PG8_SA(0, 0), cA, voffA); PG8_STAGE(PG8_SB(0, 1), cB + hstep, voffB); PG8_STAGE(PG8_SA(0, 1), cA + hstep, voffA);
        if (wr == 1) PG8_BAR;
        PG8_WAIT_V(4); PG8_BAR;
        PG8_STAGE(PG8_SB(1, 0), cB + kstep, voffB); PG8_STAGE(PG8_SA(1, 0), cA + kstep, voffA); PG8_STAGE(PG8_SB(1, 1), cB + hstep + kstep, voffB);
        PG8_WAIT_V(6); PG8_BAR;
    }
    for (;;) {
        const bool has_next = S.next(ui + 1, nxt);
        const char* nA = has_next ? (const char*)g.A + (size_t)nxt.pm * tstep : cA; const char* nB = has_next ? (const char*)g.Bt + (size_t)nxt.pn * tstep : cB;
        for (int t = 0; t < nt; t += 2) {
            const bool last = (t == nt - 2);
            const char* a1 = cA + (size_t)(t + 1) * kstep;
            const char* a2 = last ? nA : cA + (size_t)(t + 2) * kstep; const char* b2 = last ? nB : cB + (size_t)(t + 2) * kstep;
            const char* a3 = a2 + kstep; const char* b3 = b2 + kstep;
            if (last && has_next) S.a_ready(nxt);
            if constexpr (SP2) {
            PG8_LDB(B0, 0, 0); PG8_LDB(B1, 0, 1); PG8_SCHED; PG8_LDA(At, 0, 0); PG8_STAGE(PG8_SA(1, 1), a1 + hstep, voffA);
            PG8_WAIT_V(8); PG8_WAIT_L(0); PG8_BAR; PG8_MMA(0, 0, At, B0); PG8_MMA(0, 1, At, B1); PG8_BAR; PG8_SCHED;
            PG8_LDA(At, 0, 1); PG8_STAGE(PG8_SB(0, 0), b2, voffB); PG8_STAGE(PG8_SB(0, 1), b2 + hstep, voffB); PG8_STAGE(PG8_SA(0, 0), a2, voffA);
            PG8_WAIT_V(8); PG8_WAIT_L(0); PG8_BAR; PG8_MMA(1, 0, At, B0); PG8_MMA(1, 1, At, B1); PG8_BAR; PG8_SCHED;
            PG8_LDB(B0, 1, 0); PG8_LDB(B1, 1, 1); PG8_SCHED; PG8_LDA(At, 1, 0); PG8_STAGE(PG8_SA(0, 1), a2 + hstep, voffA);
            PG8_WAIT_V(8); PG8_WAIT_L(0); PG8_BAR; PG8_MMA(0, 0, At, B0); PG8_MMA(0, 1, At, B1); PG8_BAR; PG8_SCHED;
            PG8_LDA(At, 1, 1); PG8_STAGE(PG8_SB(1, 0), b3, voffB); PG8_STAGE(PG8_SB(1, 1), b3 + hstep, voffB); PG8_STAGE(PG8_SA(1, 0), a3, voffA);
            PG8_WAIT_V(8); PG8_WAIT_L(0); PG8_BAR; PG8_MMA(1, 0, At, B0); PG8_MMA(1, 1, At, B1); PG8_BAR; PG8_SCHED;
            } else {
            PG8_LDB(B0, 0, 0); PG8_SCHED; PG8_LDA(At, 0, 0); PG8_STAGE(PG8_SA(1, 1), a1 + hstep, voffA);
            PG8_WAIT_L(8); PG8_BAR; PG8_WAIT_L(0); PG8_MMA(0, 0, At, B0); PG8_BAR; PG8_SCHED;
            PG8_LDB(B1, 0, 1); PG8_STAGE(PG8_SB(0, 0), b2, voffB);
            PG8_BAR; PG8_WAIT_L(0); PG8_MMA(0, 1, At, B1); PG8_BAR;
            PG8_LDA(At, 0, 1); PG8_STAGE(PG8_SA(0, 0), a2, voffA);
            PG8_BAR; PG8_WAIT_L(0); PG8_MMA(1, 0, At, B0); PG8_BAR; PG8_SCHED;
            PG8_STAGE(PG8_SB(0, 1), b2 + hstep, voffB);
            PG8_WAIT_V(6); PG8_BAR; PG8_MMA(1, 1, At, B1); PG8_BAR;
            PG8_LDB(B0, 1, 0); PG8_SCHED; PG8_LDA(At, 1, 0); PG8_STAGE(PG8_SA(0, 1), a2 + hstep, voffA);
            PG8_WAIT_L(8); PG8_BAR; PG8_WAIT_L(0); PG8_MMA(0, 0, At, B0); PG8_BAR; PG8_SCHED;
            PG8_LDB(B1, 1, 1); PG8_STAGE(PG8_SB(1, 0), b3, voffB);
            PG8_BAR; PG8_WAIT_L(0); PG8_MMA(0, 1, At, B1); PG8_BAR;
            PG8_LDA(At, 1, 1); PG8_STAGE(PG8_SA(1, 0), a3, voffA);
            PG8_BAR; PG8_WAIT_L(0); PG8_MMA(1, 0, At, B0); PG8_BAR; PG8_SCHED;
            PG8_STAGE(PG8_SB(1, 1), b3 + hstep, voffB);
            PG8_WAIT_V(6); PG8_BAR; PG8_MMA(1, 1, At, B1); PG8_BAR;
            }
        }
        if constexpr (ALIGN_EPI) { if (wr == 0) PG8_BAR; }
        if constexpr (!Epi::AFTER_DRAIN) { E(acc, cur, wr, wc, fr, fq, ldsx, ui, wid, lane); S.done(cur); }
        if (!has_next) break;
#pragma unroll
        for (int a = 0; a < 2; ++a)
#pragma unroll
            for (int b = 0; b < 2; ++b)
#pragma unroll
                for (int m = 0; m < 4; ++m)
#pragma unroll
                    for (int n = 0; n < 2; ++n) acc[a][b][m][n] = (f32x4){0.f, 0.f, 0.f, 0.f};
        cur = nxt; cA = nA; cB = nB; ++ui;
        if constexpr (ALIGN_EPI) { if (wr == 1) PG8_BAR; }
    }
    PG8_WAIT_V(0);
    if constexpr (!ALIGN_EPI) { if (wr == 0) PG8_BAR; }
    PG8_BAR;
    if constexpr (Epi::AFTER_DRAIN) { E.fused(acc, cur, wr, wc, fr, fq, lds, wid, lane); S.done(cur); }
#undef PG8_SA
#undef PG8_SB
#undef PG8_STAGE
#undef PG8_LDA
#undef PG8_LDB
#undef PG8_MMA
#undef PG8_WAIT_V
#undef PG8_WAIT_L
#undef PG8_BAR
#undef PG8_SCHED
}
}
namespace att {
typedef __attribute__((address_space(3))) unsigned char lds_u8;
typedef unsigned short bf16_t;
typedef short bf16x8 __attribute__((ext_vector_type(8)));
typedef short v4i16 __attribute__((ext_vector_type(4)));
typedef float f32x16 __attribute__((ext_vector_type(16)));
typedef float f32x4 __attribute__((ext_vector_type(4)));
typedef unsigned u32x4 __attribute__((ext_vector_type(4)));
typedef unsigned u32x2 __attribute__((ext_vector_type(2)));
typedef float f32x2 __attribute__((ext_vector_type(2)));
#define ATT_LAS __attribute__((address_space(3)))
constexpr int KROWB = 144, NKEY = 384, LDS_K = 0, LDS_V = NKEY * KROWB  , VBLK = NKEY * 64  , LDS_BT = LDS_V + 2 * VBLK  , LDS_NT = LDS_BT + 5 * 4096  , LDS_TB = LDS_NT + 4096  , LDS_END = LDS_TB + 1024;
constexpr float NEG_BIG = -1.0e30f;
typedef __bf16 bf16x2_c __attribute__((ext_vector_type(2)));
__device__ __forceinline__ unsigned cvtpk(float lo, float hi) { const f32x2 v = {lo, hi}; const bf16x2_c b = __builtin_convertvector(v, bf16x2_c); return __builtin_bit_cast(unsigned, b); }
__device__ __forceinline__ float bf_lo(unsigned w) { return __builtin_bit_cast(float, w << 16); }
__device__ __forceinline__ float bf_hi(unsigned w) { return __builtin_bit_cast(float, w & 0xffff0000u); }
__device__ __forceinline__ int t5_bucket(int n) {
    if (n < 16) return n;
    int large = 16 + (int)(logf((float)n / 16.0f) / 4.852030263919617f * 16.0f);
    return large < 31 ? large : 31;
}
struct Unit { int b, h, dil, res, l0; };
struct Bufs { const bf16_t* Q; const bf16_t* K; const bf16_t* V; const float* rel_bias; bf16_t* Oa; bf16_t* Ob; float* STa; float* STb; bf16_t* Oout; };
struct Pre { u32x4 k[6], v[6]; };

template <bool FINAL> __device__ __forceinline__ Unit decode(int i, int G) {
    Unit u; int bh, sub;
    if (G == 256) { const int x = blockIdx.x & 7, c32 = blockIdx.x >> 3, c16 = c32 & 15; const int h = 2 * x + (c32 >> 4);
        if (FINAL) { bh = i * 16 + h; sub = c16; } else { bh = (i >> 1) * 16 + h; sub = 2 * c16 + (i & 1); } }
    else { const int uu = blockIdx.x + i * G; bh = uu & 255; sub = uu >> 8; }
    u.b = bh >> 4; u.h = bh & 15;
    if (FINAL) { u.dil = 16; u.res = sub; u.l0 = 0; }
    else if (sub < 16) { u.dil = 1; u.res = 0; u.l0 = 256 * sub; }
    else { u.dil = 4; u.res = sub & 3; u.l0 = 256 * ((sub & 15) >> 2); }
    return u;
}
template <bool FINAL> __device__ __forceinline__ int unit_count(int G) { const int total = FINAL ? 256 * 16 : 256 * 32; if (G == 256) return total / 256; return (total - (int)blockIdx.x + G - 1) / G; }
__device__ __forceinline__ void prefetch(Pre& P, const Unit& u, const Bufs& B, int tid, int wid, int q, int hi) {
    const size_t ubase = ((size_t)(u.b * NH + u.h) * SEQ + u.res) * HD; const bf16_t* Kp = B.K + ubase; const bf16_t* Vp = B.V + ubase;
    const int lsh = 6 + (u.dil == 1 ? 0 : (u.dil == 4 ? 2 : 4)), lb = u.l0 - 128;
#pragma unroll
    for (int j = 0; j < 6; ++j) { const int c = tid + 512 * j; int l = lb + (c >> 3); l = l < 0 ? 0 : l; const unsigned off = ((unsigned)l << lsh) + (unsigned)(c & 7) * 8u;
        P.k[j] = *(const u32x4*)(Kp + off); P.v[j] = *(const u32x4*)(Vp + off); }
}

template <bool FINAL>
__device__ __forceinline__ void attn_phase(lds_u8* lds, const Bufs& B) {
    int tid_ = threadIdx.x; asm volatile("" : "+v"(tid_));
    const int tid = tid_, lane = tid & 63, q = lane & 31, hi = lane >> 5; const int wid = __builtin_amdgcn_readfirstlane(tid >> 6);
    const int G = gridDim.x;
    const int nmine = unit_count<FINAL>(G); int ui = 0; if (nmine <= 0) return;
    ATT_LAS float* tb = (ATT_LAS float*)(lds + LDS_TB); ATT_LAS float* BT = (ATT_LAS float*)(lds + LDS_BT);
    Unit u = decode<FINAL>(0, G); Pre P; prefetch(P, u, B, tid, wid, q, hi);
    bf16x8 qn[4];
    if (!FINAL) { const size_t qt0 = (size_t)(u.b * NH + u.h) * SEQ + (size_t)(u.l0 + 32 * wid + q) * u.dil + u.res;
#pragma unroll
      for (int ks = 0; ks < 4; ++ks) qn[ks] = *(const bf16x8*)(B.Q + qt0 * HD + ks * 16 + hi * 8); }
    int tkey = -1;
    const int kbase = LDS_K + (32 * wid + q) * KROWB + hi * 16;
    const int g = lane >> 4, i16 = lane & 15;
    const int vbase = LDS_V + (32 * wid + 4 * (g >> 1) + (i16 >> 2)) * 64 + (16 * (g & 1) + 4 * (i16 & 3)) * 2;
    for (;;) {
        if (u.h * 32 + u.dil != tkey) { tkey = u.h * 32 + u.dil;
            if (tid < 129) tb[tid] = B.rel_bias[t5_bucket(tid * u.dil) * NH + u.h] * LOG2E;
            __syncthreads();
#pragma unroll
            for (int i = 0; i < 10; ++i) { const int idx = tid + 512 * i, j = idx & 3, ln = (idx >> 2) & 63, gq = (idx >> 8) & 3, kb = idx >> 10;
                const int delta = 128 - 32 * kb + (ln & 31) - (j + 8 * gq + 4 * (ln >> 5));
                BT[idx] = (delta >= 0 && delta <= 128) ? tb[delta < 0 ? 0 : (delta > 128 ? 128 : delta)] : NEG_BIG; }
#pragma unroll
            for (int i = 0; i < 2; ++i) BT[5 * 1024 + tid + 512 * i] = NEG_BIG; }
        const Unit cu = u; const int qpos = (cu.l0 + 32 * wid + q) * cu.dil + cu.res;
        const size_t qhm = (size_t)(cu.b * NH + cu.h) * SEQ + qpos;
        const size_t qtok = (size_t)cu.b * SEQ + qpos; const int hoff = cu.h * HD;
        bf16x8 qf[4];
#pragma unroll
        for (int ks = 0; ks < 4; ++ks) qf[ks] = FINAL ? *(const bf16x8*)(B.Q + qhm * HD + ks * 16 + hi * 8) : qn[ks];
#pragma unroll
        for (int j = 0; j < 6; ++j) { const int c = tid + 512 * j, row = c >> 3, ch = c & 7;
            *(ATT_LAS u32x4*)(lds + LDS_K + row * KROWB + ch * 16) = P.k[j];
            *(ATT_LAS u32x4*)(lds + LDS_V + (ch >> 2) * VBLK + row * 64 + (ch & 3) * 16) = P.v[j]; }
        __syncthreads();
        const bool has_next = ui + 1 < nmine;
        if (has_next) { u = decode<FINAL>(ui + 1, G); prefetch(P, u, B, tid, wid, q, hi); }
        const int kb0 = (cu.l0 == 0) ? (4 - wid > 0 ? 4 - wid : 0) : 0;
        f32x16 s[5];
#pragma unroll
        for (int kb = 0; kb < 5; ++kb) {
            if (!FINAL) {
                const int tsel = __builtin_amdgcn_readfirstlane(kb >= kb0 ? kb : 5);
#pragma unroll
                for (int gq = 0; gq < 4; ++gq) { const f32x4 t = *(const ATT_LAS f32x4*)(BT + ((tsel * 4 + gq) * 64 + lane) * 4);
                    s[kb][4 * gq] = t[0]; s[kb][4 * gq + 1] = t[1]; s[kb][4 * gq + 2] = t[2]; s[kb][4 * gq + 3] = t[3]; }
#pragma unroll
                for (int ks = 0; ks < 4; ++ks) { const bf16x8 kf = *(const ATT_LAS bf16x8*)(lds + kbase + kb * 32 * KROWB + ks * 32);
                    s[kb] = __builtin_amdgcn_mfma_f32_32x32x16_bf16(kf, qf[ks], s[kb], 0, 0, 0); }
            } else if (kb >= kb0) {
#pragma unroll
                for (int gq = 0; gq < 4; ++gq) { const f32x4 t = *(const ATT_LAS f32x4*)(BT + ((kb * 4 + gq) * 64 + lane) * 4); s[kb][4 * gq] = t[0]; s[kb][4 * gq + 1] = t[1]; s[kb][4 * gq + 2] = t[2]; s[kb][4 * gq + 3] = t[3]; }
#pragma unroll
                for (int ks = 0; ks < 4; ++ks) { const bf16x8 kf = *(const ATT_LAS bf16x8*)(lds + kbase + kb * 32 * KROWB + ks * 32);
                    s[kb] = __builtin_amdgcn_mfma_f32_32x32x16_bf16(kf, qf[ks], s[kb], 0, 0, 0); }
            } else {
#pragma unroll
                for (int r = 0; r < 16; ++r) s[kb][r] = NEG_BIG;
            }
        }
        float mx = NEG_BIG;
#pragma unroll
        for (int kb = 0; kb < 5; ++kb)
#pragma unroll
            for (int r = 0; r < 16; ++r) mx = fmaxf(mx, s[kb][r]);
        mx = fmaxf(mx, __shfl_xor(mx, 32));
        float lsum = 0.f; f32x16 o0 = {}, o1 = {};
        f32x2 st1 = {0.f, 0.f}, st2 = {0.f, 0.f}; u32x2 xa[4][2], xb[4][2];
#pragma unroll
        for (int kb = 0; kb < 5; ++kb) {
            if (!FINAL || kb >= kb0) {
#pragma unroll
                for (int r = 0; r < 16; ++r) { s[kb][r] = __builtin_amdgcn_exp2f(s[kb][r] - mx); lsum += s[kb][r]; }
                u32x4 pw0, pw1;
                pw0.x = cvtpk(s[kb][0], s[kb][1]); pw0.y = cvtpk(s[kb][2], s[kb][3]); pw0.z = cvtpk(s[kb][4], s[kb][5]); pw0.w = cvtpk(s[kb][6], s[kb][7]);
                pw1.x = cvtpk(s[kb][8], s[kb][9]); pw1.y = cvtpk(s[kb][10], s[kb][11]); pw1.z = cvtpk(s[kb][12], s[kb][13]); pw1.w = cvtpk(s[kb][14], s[kb][15]);
                const bf16x8 p0 = __builtin_bit_cast(bf16x8, pw0), p1 = __builtin_bit_cast(bf16x8, pw1);
#pragma unroll
                for (int db = 0; db < 2; ++db) {
                    const int a = vbase + db * VBLK + kb * 32 * 64;
                    const v4i16 a0 = __builtin_amdgcn_ds_read_tr16_b64_v4i16((ATT_LAS v4i16*)(lds + a));
                    const v4i16 a1 = __builtin_amdgcn_ds_read_tr16_b64_v4i16((ATT_LAS v4i16*)(lds + a + 8 * 64));
                    const v4i16 a2 = __builtin_amdgcn_ds_read_tr16_b64_v4i16((ATT_LAS v4i16*)(lds + a + 16 * 64));
                    const v4i16 a3 = __builtin_amdgcn_ds_read_tr16_b64_v4i16((ATT_LAS v4i16*)(lds + a + 24 * 64));
                    const bf16x8 v0 = (bf16x8){a0[0], a0[1], a0[2], a0[3], a1[0], a1[1], a1[2], a1[3]};
                    const bf16x8 v1 = (bf16x8){a2[0], a2[1], a2[2], a2[3], a3[0], a3[1], a3[2], a3[3]};
                    if (db == 0) { o0 = __builtin_amdgcn_mfma_f32_32x32x16_bf16(v0, p0, o0, 0, 0, 0); o0 = __builtin_amdgcn_mfma_f32_32x32x16_bf16(v1, p1, o0, 0, 0, 0); }
                    else         { o1 = __builtin_amdgcn_mfma_f32_32x32x16_bf16(v0, p0, o1, 0, 0, 0); o1 = __builtin_amdgcn_mfma_f32_32x32x16_bf16(v1, p1, o1, 0, 0, 0); }
                }
            }
            if (kb == 2) __builtin_amdgcn_sched_barrier(0);
            if (FINAL && kb == 2) {
            st1 = *(const f32x2*)(B.STa + qhm * 2); st2 = *(const f32x2*)(B.STb + qhm * 2);
            const size_t ooff = qhm * HD + 4 * hi;
#pragma unroll
            for (int gq = 0; gq < 4; ++gq)
#pragma unroll
                for (int db = 0; db < 2; ++db) { xa[gq][db] = *(const u32x2*)(B.Oa + ooff + 32 * db + 8 * gq); xb[gq][db] = *(const u32x2*)(B.Ob + ooff + 32 * db + 8 * gq); }
            }
            if (!FINAL && kb == 2 && has_next) { const size_t qt1 = (size_t)(u.b * NH + u.h) * SEQ + (size_t)(u.l0 + 32 * wid + q) * u.dil + u.res;
#pragma unroll
                for (int ks = 0; ks < 4; ++ks) qn[ks] = *(const bf16x8*)(B.Q + qt1 * HD + ks * 16 + hi * 8); }
        }
        const float l_tot = lsum + __shfl_xor(lsum, 32);
        u32x2 ow[8];
        bf16_t* orow;
        if (!FINAL) {
            const float inv = 1.0f / l_tot;
#pragma unroll
            for (int gq = 0; gq < 4; ++gq) {
                ow[gq].x = cvtpk(o0[4 * gq] * inv, o0[4 * gq + 1] * inv); ow[gq].y = cvtpk(o0[4 * gq + 2] * inv, o0[4 * gq + 3] * inv);
                ow[4 + gq].x = cvtpk(o1[4 * gq] * inv, o1[4 * gq + 1] * inv); ow[4 + gq].y = cvtpk(o1[4 * gq + 2] * inv, o1[4 * gq + 3] * inv); }
            orow = (cu.dil == 1 ? B.Oa : B.Ob) + qhm * HD;
            if (hi == 0) *(f32x2*)((cu.dil == 1 ? B.STa : B.STb) + qhm * 2) = (f32x2){mx, l_tot};
        } else {
            const f32x2 s1 = st1, s2 = st2;
            const float m_all = fmaxf(fmaxf(s1.x, s2.x), mx);
            const float e1 = s1.y * __builtin_amdgcn_exp2f(s1.x - m_all), e2 = s2.y * __builtin_amdgcn_exp2f(s2.x - m_all), e3 = __builtin_amdgcn_exp2f(mx - m_all);
            const float inv = 1.0f / (e1 + e2 + e3 * l_tot);
            const float c1 = e1 * inv, c2 = e2 * inv, c3 = e3 * inv;
#pragma unroll
            for (int gq = 0; gq < 4; ++gq) {
#pragma unroll
                for (int db = 0; db < 2; ++db) {
                    const u32x2 x1 = xa[gq][db], x2 = xb[gq][db];
                    const float a0 = db == 0 ? o0[4 * gq] : o1[4 * gq], a1 = db == 0 ? o0[4 * gq + 1] : o1[4 * gq + 1], a2 = db == 0 ? o0[4 * gq + 2] : o1[4 * gq + 2], a3 = db == 0 ? o0[4 * gq + 3] : o1[4 * gq + 3];
                    u32x2 w; w.x = cvtpk(c1 * bf_lo(x1.x) + c2 * bf_lo(x2.x) + c3 * a0, c1 * bf_hi(x1.x) + c2 * bf_hi(x2.x) + c3 * a1);
                    w.y = cvtpk(c1 * bf_lo(x1.y) + c2 * bf_lo(x2.y) + c3 * a2, c1 * bf_hi(x1.y) + c2 * bf_hi(x2.y) + c3 * a3);
                    ow[4 * db + gq] = w; } }
            orow = B.Oout + qtok * DM + hoff;
        }
#pragma unroll
        for (int pp = 0; pp < 4; ++pp) { u32x2 a = ow[2 * pp], b = ow[2 * pp + 1];
            { auto r = __builtin_amdgcn_permlane32_swap(a.x, b.x, false, false); a.x = r[0]; b.x = r[1]; }
            { auto r = __builtin_amdgcn_permlane32_swap(a.y, b.y, false, false); a.y = r[0]; b.y = r[1]; }
            *(u32x4*)(orow + 16 * pp + 8 * hi) = (u32x4){a.x, a.y, b.x, b.y}; }
        __syncthreads();
        if (!has_next) break;
        ++ui;
    }
}
}

#define LAS __attribute__((address_space(3)))
typedef unsigned short bf16;
typedef unsigned v4u __attribute__((ext_vector_type(4)));
typedef unsigned v2u __attribute__((ext_vector_type(2)));
typedef float f32x4 __attribute__((ext_vector_type(4)));
constexpr int NWAVES = 8, NTHREADS = 512;
constexpr size_t MiB = 1u << 20;
constexpr size_t WS_SS = 0;
constexpr size_t WS_E = 4 * MiB;
constexpr size_t WS_BAR = 46 * MiB, WS_BAR_BYTES = 16384;
constexpr size_t WS_ST = 28 * MiB;
constexpr size_t WS_WIN = 48 * MiB, WS_WOUT = 54 * MiB, WS_WUP0 = 56 * MiB, WS_WUP1 = 67 * MiB, WS_WD0 = 78 * MiB, WS_WD1 = 84 * MiB, WS_WQKV = 90 * MiB, WS_WO = 96 * MiB;
constexpr size_t WS_XN = 128 * MiB;
constexpr size_t WS_BIG = 256 * MiB;
constexpr size_t WS_O = 640 * MiB;
constexpr size_t WS_O2 = 768 * MiB;
constexpr size_t WS_OF = 896 * MiB;
constexpr size_t WS_END = 1024 * MiB;
constexpr int LDS_RING = 131072, LDS_X = LDS_RING, LDS_MISC = LDS_RING + 24576  , LDS_BYTES = LDS_MISC + 64;

__device__ __forceinline__ unsigned f2bf(float f) { unsigned u = __builtin_bit_cast(unsigned, f); return (u + 0x7fffu + ((u >> 16) & 1u)) >> 16; }
__device__ __forceinline__ unsigned pk2(float lo, float hi) { return f2bf(lo) | (f2bf(hi) << 16); }
__device__ __forceinline__ float bflo(unsigned w) { return __builtin_bit_cast(float, w << 16); }
__device__ __forceinline__ float bfhi(unsigned w) { return __builtin_bit_cast(float, w & 0xffff0000u); }
__device__ __forceinline__ float wave_sum(float v) {
#pragma unroll
    for (int o = 1; o < 64; o <<= 1) v += __shfl_xor(v, o);
    return v;
}
__device__ __forceinline__ void transpose_item(const float* W, int K, int N, const float* gain, bf16* WT, int k0, int n0, int drow0, LAS float* scr, int lane) {
    float wv[32];
#pragma unroll
    for (int i = 0; i < 32; ++i) wv[i] = W[(size_t)(k0 + 2 * i + (lane >> 5)) * N + n0 + (lane & 31)];
#pragma unroll
    for (int i = 0; i < 32; ++i) { const int kk = 2 * i + (lane >> 5); const float gk = gain ? gain[k0 + kk] : 1.0f; scr[kk * 33 + (lane & 31)] = wv[i] * gk; }
    asm volatile("s_waitcnt lgkmcnt(0)" ::: "memory");
    const int c = lane & 7;
#pragma unroll
    for (int j = 0; j < 4; ++j) { const int n = (lane >> 3) + 8 * j; const LAS float* s = scr + (8 * c) * 33 + n;
        v4u o; o.x = pk2(s[0 * 33], s[1 * 33]); o.y = pk2(s[2 * 33], s[3 * 33]); o.z = pk2(s[4 * 33], s[5 * 33]); o.w = pk2(s[6 * 33], s[7 * 33]);
        *(v4u*)(WT + (size_t)(drow0 + n) * K + k0 + 8 * c) = o; }
    asm volatile("s_waitcnt lgkmcnt(0)" ::: "memory");
}
template <int MODE> __device__ __forceinline__ int dest_row(int n0) {
    if (MODE == 0) return n0;
    if (MODE == 1) { if (n0 < DM) return n0; const int part = (n0 - DM) / DM  , j = (n0 - DM) % DM; return DM + (j / 128) * 256 + part * 128 + (j % 128); }
    { const int part = n0 / FF, j = n0 % FF; return (j / 128) * 256 + part * 128 + (j % 128); }
}
template <int MODE> __device__ __forceinline__ void convert_matrix(const float* W, int K, int N, const float* gain, bf16* WT, int row_off, LAS float* scr, int gw, int ngw, int lane) {
    const int nblk = N / 32, items = (K / 64) * nblk;
    for (int it = gw; it < items; it += ngw) { const int kb = it / nblk, nb = it % nblk; transpose_item(W, K, N, gain, WT, 64 * kb, 32 * nb, row_off + dest_row<MODE>(32 * nb), scr, lane); }
}

typedef unsigned v4u_unused_;
#define XB_TMO      128
#define XB_XCNT(j)  (256  + 64 * (j))
#define XB_XSUB(j)  (1280 + 64 * (j))
#define XB_XGEN(j)  (2304 + 64 * (j))
#define XB_TOP      3328
#define XB_TOPGEN   3392
#define XCD_BAR_WORDS 3456
#define XB_SPIN_CAP (1u << 18)

__device__ __forceinline__ unsigned xb_ld(unsigned* p)              { return __hip_atomic_load(p, __ATOMIC_RELAXED, __HIP_MEMORY_SCOPE_AGENT); }
__device__ __forceinline__ unsigned xb_add(unsigned* p, unsigned v) { return __hip_atomic_fetch_add(p, v, __ATOMIC_RELAXED, __HIP_MEMORY_SCOPE_AGENT); }
__device__ __forceinline__ unsigned xb_xcc_id() { return (unsigned)__builtin_amdgcn_s_getreg((3 << 11) | 20) & 0xFu; }
#define XB_SPIN(cond, bar) do { unsigned _sp = 0; while (cond) { __builtin_amdgcn_s_sleep(1); \
    if ((++_sp & 255u) == 0u) { if (xb_ld(&(bar)[XB_TMO])) break; if (_sp > XB_SPIN_CAP) { atomicAdd(&(bar)[XB_TMO], 1u); break; } } } } while (0)

struct XcdBarrier {
    unsigned* bar; unsigned x;
    volatile LAS unsigned* st;
};

__device__ __forceinline__ XcdBarrier xcd_barrier_post(unsigned* bar, volatile LAS unsigned* st) {
    XcdBarrier b; b.bar = bar; b.x = xb_xcc_id(); b.st = st;
    if (threadIdx.x == 0) (void)xb_add(&bar[XB_XCNT(b.x)], 1u);
    return b;
}
__device__ __forceinline__ void xcd_barrier_complete(unsigned* bar, unsigned x, unsigned& nloc, unsigned& nx) {
    const unsigned G = gridDim.x * gridDim.y * gridDim.z;
    unsigned sum, cnt, mine, sp = 0u;
    for (;;) {
        sum = 0u; cnt = 0u; mine = 0u;
#pragma unroll
        for (unsigned j = 0; j < 16; ++j) { const unsigned c = xb_ld(&bar[XB_XCNT(j)]); sum += c; cnt += (c > 0u) ? 1u : 0u; mine = (j == x) ? c : mine; }
        if (sum == G) break;
        __builtin_amdgcn_s_sleep(1);
        if ((++sp & 255u) == 0u) { if (xb_ld(&bar[XB_TMO])) break; if (sp > XB_SPIN_CAP) { atomicAdd(&bar[XB_TMO], 1u); break; } }
    }
    nloc = mine > 0u ? mine : 1u; nx = cnt > 0u ? cnt : 1u;
}

__device__ __forceinline__ void xcd_barrier(const XcdBarrier& b) {
    asm volatile("s_waitcnt vmcnt(0)" ::: "memory");
    __syncthreads();
    if (threadIdx.x == 0) {
        unsigned* bar = b.bar;
        __builtin_amdgcn_s_waitcnt(0);
        unsigned nloc = b.st[0], nx = b.st[1];
        if (nloc == 0u) { xcd_barrier_complete(bar, b.x, nloc, nx); b.st[0] = nloc; b.st[1] = nx; }
        const unsigned old = xb_add(&bar[XB_XSUB(b.x)], 1u);
        const unsigned gen = old / nloc;
        if (old + 1u == (gen + 1u) * nloc) {
            __builtin_amdgcn_fence(__ATOMIC_RELEASE, "agent");
            asm volatile("s_waitcnt vmcnt(0)" ::: "memory");
            const unsigned og = xb_add(&bar[XB_TOP], 1u);
            const unsigned tg = og / nx;
            if (og + 1u == (tg + 1u) * nx) xb_add(&bar[XB_TOPGEN], 1u);
            else XB_SPIN(xb_ld(&bar[XB_TOPGEN]) == tg, bar);
            __builtin_amdgcn_fence(__ATOMIC_ACQUIRE, "agent");
            xb_add(&bar[XB_XGEN(b.x)], 1u);
            asm volatile("s_waitcnt vmcnt(0)" ::: "memory");
        } else {
            XB_SPIN(xb_ld(&bar[XB_XGEN(b.x)]) == gen, bar);
            __builtin_amdgcn_fence(__ATOMIC_ACQUIRE, "agent");
            asm volatile("s_waitcnt vmcnt(0)" ::: "memory");
        }
    }
    __syncthreads();
}

struct Args {
    const float* x; const float* a_norm; const float* a_w_in; const float* a_conv; const float* a_w_out; const float* kv_norm; const float* w_kv; const float* b_norm; const float* b_w_q; const float* b_w_o;
    const float* rel_bias; const float* ffn_norm; const float* ffn_w_up; const float* ffn_conv; const float* ffn_conv_b; const float* ffn_w_down; const float* final_norm;
    float* out; unsigned char* ws;
};

template <class Epi> __device__ __forceinline__ void run_gemm(LAS unsigned char* lds, const bf16* A, const bf16* Bt, int N, int K, const Epi& E) {
    pg8::Gemm g{A, Bt, MT, N, K}; pg8::StaticOrder S; S.init(MT, N, (int)gridDim.x, (int)blockIdx.x);
    pg8::gemm_phase<Epi, pg8::StaticOrder, true, true>(lds, lds + LDS_X, g, S, E);
}

__device__ __forceinline__ void ffn_fixup(const float* E, const float* cw, const float* cb, bf16* ACT, int gtid, int gthreads) {
    const int per = FF / 4, total = 256 * per;
    for (int it = gtid; it < total; it += gthreads) { const int pm = it / per, a = (it % per) * 4;
        if ((pm & 15) == 0) continue;
        const int pn = a >> 7, j7 = a & 127, eg = 256 * pn + j7;
        const float* Ec = E + (size_t)pm * 4 * FF2; const float* Ep = E + (size_t)(pm - 1) * 4 * FF2;
        f32x4 uu[2][2];
#pragma unroll
        for (int part = 0; part < 2; ++part) { const int e = eg + part * 128, oc = part * FF + a;
            const f32x4 w0 = *(const f32x4*)(cw + oc), w1 = *(const f32x4*)(cw + FF2 + oc), w2 = *(const f32x4*)(cw + 2 * FF2 + oc), bb = *(const f32x4*)(cb + oc);
            const f32x4 r0 = *(const f32x4*)(Ec + e), r1 = *(const f32x4*)(Ec + FF2 + e), pm2 = *(const f32x4*)(Ep + 2 * FF2 + e), pm1 = *(const f32x4*)(Ep + 3 * FF2 + e);
            uu[part][0] = w2 * r0 + w1 * pm1 + w0 * pm2 + bb; uu[part][1] = w2 * r1 + w1 * r0 + w0 * pm1 + bb; }
#pragma unroll
        for (int j = 0; j < 2; ++j) { f32x4 o;
#pragma unroll
            for (int i = 0; i < 4; ++i) o[i] = pg8::silu_f(uu[0][j][i]) * uu[1][j][i];
            v2u w; w.x = pk2(o[0], o[1]); w.y = pk2(o[2], o[3]); *(v2u*)(ACT + (size_t)(pm * 256 + j) * FF + a) = w; }
    }
}

#ifndef DUP_MASK
#define DUP_MASK 0
#endif
#define PH(k) for (int rep_ = 0; rep_ < 1 + ((DUP_MASK >> (k)) & 1); ++rep_)
#define a (*ap_)
__global__ void __launch_bounds__(NTHREADS, 2) yoco_fwd(Args a_unused) {
    extern __shared__ __attribute__((aligned(16))) unsigned char lds_raw[];
    LAS unsigned char* lds = (LAS unsigned char*)lds_raw;
    cg::grid_group grid = cg::this_grid();
    volatile LAS unsigned* MISC = (volatile LAS unsigned*)(lds + LDS_MISC);
    if (threadIdx.x < 2) MISC[threadIdx.x] = 0u;
    __syncthreads();
    typedef const __attribute__((address_space(4))) Args* ArgsP;
    const ArgsP ap0 = (ArgsP)__builtin_amdgcn_kernarg_segment_ptr();
    if (blockIdx.x == 0) { unsigned* bw = (unsigned*)(ap0->ws + WS_BAR); for (int i = threadIdx.x; i < (int)(WS_BAR_BYTES / 4); i += NTHREADS) bw[i] = 0u; }
#define GRID_BAR() do { XcdBarrier b_; b_.bar = (unsigned*)(ap0->ws + WS_BAR); b_.x = xb_xcc_id(); b_.st = MISC; xcd_barrier(b_); } while (0)
#define PHASE_ARGS() ArgsP ap_ = ap0; asm volatile("" : "+s"(ap_)); unsigned char* ws = ap_->ws; \
    int tid_ = threadIdx.x; asm volatile("" : "+v"(tid_)); const int tid = tid_, lane = tid & 63, wave = __builtin_amdgcn_readfirstlane(tid >> 6); \
    const int G = gridDim.x, gw = blockIdx.x * NWAVES + wave, ngw = G * NWAVES, gtid = blockIdx.x * NTHREADS + tid, gthreads = G * NTHREADS; (void)lane; (void)gw; (void)ngw; (void)gtid; (void)gthreads; \
    float* SS1 = (float*)(ws + WS_SS); float* SS2 = SS1 + 4 * MT; float* SS3 = SS2 + 4 * MT; float* SS4 = SS3 + 4 * MT; \
    float* EB = (float*)(ws + WS_E); float* ST1 = (float*)(ws + WS_ST); float* ST2 = ST1 + (size_t)MT * NH * 2; \
    bf16 *Win_t = (bf16*)(ws + WS_WIN), *Wout_t = (bf16*)(ws + WS_WOUT), *Wup0_t = (bf16*)(ws + WS_WUP0), *Wup1_t = (bf16*)(ws + WS_WUP1), *Wd0_t = (bf16*)(ws + WS_WD0), *Wd1_t = (bf16*)(ws + WS_WD1), \
         *Wqkv_t = (bf16*)(ws + WS_WQKV), *Wo_t = (bf16*)(ws + WS_WO); \
    bf16* XN = (bf16*)(ws + WS_XN); bf16* Bg = (bf16*)(ws + WS_BIG); bf16* CH = Bg + (size_t)MT * DM; bf16* Y = CH + (size_t)MT * DM; bf16* ACT = Bg; \
    bf16 *Qb = Bg, *Kb = CH, *Vb = Y; bf16* Ob = (bf16*)(ws + WS_O); bf16* O1 = Ob; bf16* O2 = (bf16*)(ws + WS_O2); bf16* OF = (bf16*)(ws + WS_OF); (void)OF; \
    (void)SS1; (void)SS2; (void)SS3; (void)SS4; (void)EB; (void)ST1; (void)ST2; (void)Win_t; (void)Wout_t; (void)Wup0_t; (void)Wup1_t; (void)Wd0_t; (void)Wd1_t; (void)Wqkv_t; (void)Wo_t; \
    (void)XN; (void)Bg; (void)CH; (void)Y; (void)ACT; (void)Qb; (void)Kb; (void)Vb; (void)Ob; (void)O1; (void)O2;

    PH(0) { PHASE_ARGS()
        LAS float* scr = (LAS float*)(lds + wave * 16384);
        convert_matrix<1>(a.a_w_in, DM, 3 * DM, nullptr, Win_t, 0, scr, gw, ngw, lane);
        convert_matrix<0>(a.a_w_out, DM, DM, nullptr, Wout_t, 0, scr, gw, ngw, lane);
        convert_matrix<2>(a.ffn_w_up, DM, FF2, a.ffn_norm, Wup0_t, 0, scr, gw, ngw, lane);
        convert_matrix<2>(a.ffn_w_up + (size_t)DM * FF2, DM, FF2, a.ffn_norm + DM, Wup1_t, 0, scr, gw, ngw, lane);
        convert_matrix<0>(a.ffn_w_down, FF, DM, nullptr, Wd0_t, 0, scr, gw, ngw, lane);
        convert_matrix<0>(a.ffn_w_down + (size_t)FF * DM, FF, DM, nullptr, Wd1_t, 0, scr, gw, ngw, lane);
        convert_matrix<0>(a.b_w_q, DM, DM, a.b_norm, Wqkv_t, 0, scr, gw, ngw, lane);
        convert_matrix<0>(a.w_kv, DM, 2 * DM, a.kv_norm, Wqkv_t, DM, scr, gw, ngw, lane);
        convert_matrix<0>(a.b_w_o, DM, DM, nullptr, Wo_t, 0, scr, gw, ngw, lane);
        for (int m = gw; m < MT; m += 2 * ngw) {
            const int m1 = m + ngw;
            const bool two = m1 < MT;
            const f32x4* xr0 = (const f32x4*)(a.x + (size_t)m * DM) + lane; const f32x4* xr1 = (const f32x4*)(a.x + (size_t)(two ? m1 : m) * DM) + lane;
            f32x4 v0[4], v1[4]; float s0 = 0.f, s1 = 0.f;
#pragma unroll
            for (int j = 0; j < 4; ++j) { v0[j] = xr0[64 * j]; v1[j] = xr1[64 * j]; }
#pragma unroll
            for (int j = 0; j < 4; ++j) { s0 += (v0[j].x * v0[j].x + v0[j].y * v0[j].y) + (v0[j].z * v0[j].z + v0[j].w * v0[j].w); s1 += (v1[j].x * v1[j].x + v1[j].y * v1[j].y) + (v1[j].z * v1[j].z + v1[j].w * v1[j].w); }
            const float r0 = __builtin_amdgcn_rsqf(wave_sum(s0) * (1.0f / DM) + RMS_EPS), r1 = __builtin_amdgcn_rsqf(wave_sum(s1) * (1.0f / DM) + RMS_EPS);
            v2u* o0 = (v2u*)(XN + (size_t)m * DM) + lane; v2u* o1 = (v2u*)(XN + (size_t)m1 * DM) + lane;
#pragma unroll
            for (int j = 0; j < 4; ++j) { const f32x4 gn = ((const f32x4*)a.a_norm)[lane + 64 * j];
                v2u w; w.x = pk2(v0[j].x * r0 * gn.x, v0[j].y * r0 * gn.y); w.y = pk2(v0[j].z * r0 * gn.z, v0[j].w * r0 * gn.w); o0[64 * j] = w;
                if (two) { v2u w1; w1.x = pk2(v1[j].x * r1 * gn.x, v1[j].y * r1 * gn.y); w1.y = pk2(v1[j].z * r1 * gn.z, v1[j].w * r1 * gn.w); o1[64 * j] = w1; } }
        }
    }
    grid.sync();
    (void)xcd_barrier_post((unsigned*)(ap0->ws + WS_BAR), MISC);
    PH(1) { PHASE_ARGS() pg8::EpiWin E{Bg, CH}; run_gemm(lds, XN, Win_t, 3 * DM, DM, E); }
    GRID_BAR();
    PH(2) { PHASE_ARGS()
        const int total = (MT / 8) * (DM / 8);
        const float* cw = a.a_conv;
        for (int it = gtid; it < total; it += gthreads) { const int cg8 = (it % (DM / 8)) * 8, t0 = (it / (DM / 8)) * 8;
            float w0[8], w1[8], w2[8];
#pragma unroll
            for (int i = 0; i < 8; ++i) { w0[i] = cw[cg8 + i]; w1[i] = cw[DM + cg8 + i]; w2[i] = cw[2 * DM + cg8 + i]; }
            float p2[8], p1[8];
            if ((t0 & (SEQ - 1)) == 0) {
#pragma unroll
                for (int i = 0; i < 8; ++i) { p2[i] = 0.f; p1[i] = 0.f; }
            } else { const v4u a2 = *(const v4u*)(CH + (size_t)(t0 - 2) * DM + cg8), a1 = *(const v4u*)(CH + (size_t)(t0 - 1) * DM + cg8);
                p2[0] = bflo(a2.x); p2[1] = bfhi(a2.x); p2[2] = bflo(a2.y); p2[3] = bfhi(a2.y); p2[4] = bflo(a2.z); p2[5] = bfhi(a2.z); p2[6] = bflo(a2.w); p2[7] = bfhi(a2.w);
                p1[0] = bflo(a1.x); p1[1] = bfhi(a1.x); p1[2] = bflo(a1.y); p1[3] = bfhi(a1.y); p1[4] = bflo(a1.z); p1[5] = bfhi(a1.z); p1[6] = bflo(a1.w); p1[7] = bfhi(a1.w); }
            v4u c4a[8], b4a[8];
#pragma unroll
            for (int t = 0; t < 8; ++t) { const size_t off = (size_t)(t0 + t) * DM + cg8; c4a[t] = *(const v4u*)(CH + off); b4a[t] = *(const v4u*)(Bg + off); }
#pragma unroll
            for (int t = 0; t < 8; ++t) { const size_t off = (size_t)(t0 + t) * DM + cg8; const v4u c4 = c4a[t], b4 = b4a[t];
                float c[8], bgt[8], y[8];
                c[0] = bflo(c4.x); c[1] = bfhi(c4.x); c[2] = bflo(c4.y); c[3] = bfhi(c4.y); c[4] = bflo(c4.z); c[5] = bfhi(c4.z); c[6] = bflo(c4.w); c[7] = bfhi(c4.w);
                bgt[0] = bflo(b4.x); bgt[1] = bfhi(b4.x); bgt[2] = bflo(b4.y); bgt[3] = bfhi(b4.y); bgt[4] = bflo(b4.z); bgt[5] = bfhi(b4.z); bgt[6] = bflo(b4.w); bgt[7] = bfhi(b4.w);
#pragma unroll
                for (int i = 0; i < 8; ++i) { y[i] = bgt[i] * (w2[i] * c[i] + w1[i] * p1[i] + w0[i] * p2[i]); p2[i] = p1[i]; p1[i] = c[i]; }
                v4u o; o.x = pk2(y[0], y[1]); o.y = pk2(y[2], y[3]); o.z = pk2(y[4], y[5]); o.w = pk2(y[6], y[7]); *(v4u*)(Y + off) = o; }
        }
    }
    GRID_BAR();
    PH(3) { PHASE_ARGS() pg8::EpiRes<true> E{a.x, XN, SS1}; run_gemm(lds, Y, Wout_t, DM, DM, E); }
    GRID_BAR();
    PH(4) { PHASE_ARGS() pg8::EpiFfnUp E{ACT, EB, SS1, a.ffn_conv, a.ffn_conv_b}; run_gemm(lds, XN, Wup0_t, FF2, DM, E); }
    GRID_BAR();
    PH(5) { PHASE_ARGS() ffn_fixup(EB, a.ffn_conv, a.ffn_conv_b, ACT, gtid, gthreads); }
    GRID_BAR();
    PH(6) { PHASE_ARGS() pg8::EpiRes<false> E{nullptr, XN, SS2}; run_gemm(lds, ACT, Wd0_t, DM, FF, E); }
    GRID_BAR();
    PH(7) { PHASE_ARGS() pg8::EpiQKV E{Qb, SS2, 0.125f * LOG2E}; run_gemm(lds, XN, Wqkv_t, 3 * DM, DM, E); }
    GRID_BAR();
    PH(8) { PHASE_ARGS()
        att::Bufs B{Qb, Kb, Vb, a.rel_bias, O1, O2, ST1, ST2, OF};
        att::attn_phase<false>(lds, B);
    }
    GRID_BAR();
    PH(9) { PHASE_ARGS()
        att::Bufs B{Qb, Kb, Vb, a.rel_bias, O1, O2, ST1, ST2, OF};
        att::attn_phase<true>(lds, B);
    }
    GRID_BAR();
    PH(10) { PHASE_ARGS() pg8::EpiRes<false> E{nullptr, XN, SS3}; run_gemm(lds, OF, Wo_t, DM, DM, E); }
    GRID_BAR();
    PH(11) { PHASE_ARGS() pg8::EpiFfnUp E{ACT, EB, SS3, a.ffn_conv + 3 * FF2, a.ffn_conv_b + FF2}; run_gemm(lds, XN, Wup1_t, FF2, DM, E); }
    GRID_BAR();
    PH(12) { PHASE_ARGS() ffn_fixup(EB, a.ffn_conv + 3 * FF2, a.ffn_conv_b + FF2, ACT, gtid, gthreads); }
    GRID_BAR();
    PH(13) { PHASE_ARGS() pg8::EpiRes<false> E{nullptr, XN, SS4}; run_gemm(lds, ACT, Wd1_t, DM, FF, E); }
    GRID_BAR();
    PH(14) { PHASE_ARGS() for (int m0 = gw; m0 < MT; m0 += 4 * ngw) {
        v4u hb[4][2]; float rs[4];
#pragma unroll
        for (int r = 0; r < 4; ++r) { const int m = m0 + r * ngw < MT ? m0 + r * ngw : m0; const v4u* hr = (const v4u*)(XN + (size_t)m * DM) + lane; hb[r][0] = hr[0]; hb[r][1] = hr[64]; rs[r] = pg8::row_rstd(SS4, m); }
#pragma unroll
        for (int r = 0; r < 4; ++r) { const int m = m0 + r * ngw; if (m < MT) { f32x4* xr = (f32x4*)(a.out + (size_t)m * DM);
#pragma unroll
            for (int j = 0; j < 2; ++j) { const v4u h = hb[r][j]; const int c = (lane + 64 * j) * 8; const float s = rs[r];
                const f32x4 g0 = *(const f32x4*)(a.final_norm + c), g1 = *(const f32x4*)(a.final_norm + c + 4);
                xr[(c >> 2)] = (f32x4){bflo(h.x) * s * g0.x, bfhi(h.x) * s * g0.y, bflo(h.y) * s * g0.z, bfhi(h.y) * s * g0.w};
                xr[(c >> 2) + 1] = (f32x4){bflo(h.z) * s * g1.x, bfhi(h.z) * s * g1.y, bflo(h.w) * s * g1.z, bfhi(h.w) * s * g1.w}; } } }
    } }
}

#undef a
extern "C" void kernel_launch(void* const* d_in, const int* in_sizes, int n_in, void* d_out, int out_size, void* d_ws, size_t ws_size, hipStream_t stream) {
    static int grid = 0;
    if (grid == 0) {
        if (n_in != 17 || in_sizes[0] != MT * DM || out_size != MT * DM || ws_size < WS_END) { fprintf(stderr, "kernel_launch: unexpected shapes (n_in %d, in0 %d, out %d, ws %zu)\n", n_in, n_in > 0 ? in_sizes[0] : -1, out_size, ws_size); grid = -1; return; }
        int dev = 0, cus = 0, per_cu = 0;
        hipGetDevice(&dev); hipDeviceGetAttribute(&cus, hipDeviceAttributeMultiprocessorCount, dev);
        if (hipFuncSetAttribute((const void*)yoco_fwd, hipFuncAttributeMaxDynamicSharedMemorySize, LDS_BYTES) != hipSuccess) { fprintf(stderr, "kernel_launch: hipFuncSetAttribute failed\n"); grid = -1; return; }
        if (hipOccupancyMaxActiveBlocksPerMultiprocessor(&per_cu, (const void*)yoco_fwd, NTHREADS, LDS_BYTES) != hipSuccess || per_cu < 1) { fprintf(stderr, "kernel_launch: occupancy query says %d\n", per_cu); per_cu = 1; }
        (void)hipGetLastError();
        grid = cus * 1;
    }
    if (grid < 0) return;
    Args a{};
    a.x = (const float*)d_in[0]; a.a_norm = (const float*)d_in[1]; a.a_w_in = (const float*)d_in[2]; a.a_conv = (const float*)d_in[3]; a.a_w_out = (const float*)d_in[4];
    a.kv_norm = (const float*)d_in[5]; a.w_kv = (const float*)d_in[6]; a.b_norm = (const float*)d_in[7]; a.b_w_q = (const float*)d_in[8]; a.b_w_o = (const float*)d_in[9];
    a.rel_bias = (const float*)d_in[10]; a.ffn_norm = (const float*)d_in[11]; a.ffn_w_up = (const float*)d_in[12]; a.ffn_conv = (const float*)d_in[13]; a.ffn_conv_b = (const float*)d_in[14];
    a.ffn_w_down = (const float*)d_in[15]; a.final_norm = (const float*)d_in[16];
    a.out = (float*)d_out; a.ws = (unsigned char*)d_ws;
    void* args[] = {&a};
    hipError_t e = hipLaunchCooperativeKernel((const void*)yoco_fwd, dim3(grid), dim3(NTHREADS), args, LDS_BYTES, stream);
    if (e != hipSuccess) fprintf(stderr, "cooperative launch failed: %s (grid %d)\n", hipGetErrorString(e), grid);
}
```
